# Optimizing an MI355X kernel written in HIP

```python
import jax, jax.numpy as jnp
from jax import lax
import numpy as np

D_MODEL = 1024
BATCH = 4
SEQ = 8192
DEPTH = 2

SC_WIDTH = D_MODEL // 2
SC_KERNEL = 3
MLA_HEADS = 8
MLA_NOPE = 64
MLA_ROPE = 32
MLA_V = 64
MLA_Q_RANK = 384
MLA_KV_RANK = 256
ROPE_BASE = 10000.0
Q_BLOCK = 128
IN_COLS = 3 * SC_WIDTH + MLA_Q_RANK + MLA_KV_RANK + MLA_ROPE
MIX_WIDTH = SC_WIDTH + MLA_HEADS * MLA_V
CONF_KERNEL = 31
CONF_WIDTH = D_MODEL
D_FF = 4 * D_MODEL
N_EVEN = (DEPTH + 1) // 2
N_ODD = DEPTH // 2
EPS = 1e-6

kernel_name = "hybrid_shortconv_mla_conformer_encoder"


def rms_norm(x, g):
    xf = x.astype(jnp.float32)
    y = xf * lax.rsqrt(jnp.mean(xf * xf, axis=-1, keepdims=True) + EPS)
    return (y * g.astype(jnp.float32)).astype(x.dtype)


def layer_norm(x, g, b):
    xf = x.astype(jnp.float32)
    mu = jnp.mean(xf, axis=-1, keepdims=True)
    var = jnp.mean(jnp.square(xf - mu), axis=-1, keepdims=True)
    y = (xf - mu) * lax.rsqrt(var + EPS)
    return (y * g.astype(jnp.float32) + b.astype(jnp.float32)).astype(x.dtype)


def depthwise_conv(x, w):
    k = w.shape[0]
    return lax.conv_general_dilated(
        x, w[:, None, :].astype(x.dtype), window_strides=(1,),
        padding=[(k // 2, k // 2)], dimension_numbers=('NWC', 'WIO', 'NWC'),
        feature_group_count=x.shape[-1])


def apply_rope(x, cos, sin):
    half = x.shape[-1] // 2
    xf = x.astype(jnp.float32)
    x1, x2 = xf[..., :half], xf[..., half:]
    out = jnp.concatenate([x1 * cos - x2 * sin, x2 * cos + x1 * sin], axis=-1)
    return out.astype(x.dtype)


def block_attention(q, k, v):
    b, s, h, dq = q.shape
    nblk = s // Q_BLOCK
    qb = q.reshape(b, nblk, Q_BLOCK, h, dq).transpose(1, 0, 2, 3, 4)
    kf = k.astype(jnp.float32)
    scale = dq ** -0.5

    def one_block(q_blk):
        sc = jnp.einsum('bqhd,bkhd->bhqk', q_blk.astype(jnp.float32), kf) * scale
        p = jax.nn.softmax(sc, axis=-1)
        return jnp.einsum('bhqk,bkhd->bqhd', p.astype(v.dtype), v)

    o = lax.map(one_block, qb)
    return o.transpose(1, 0, 2, 3, 4).reshape(b, s, h * v.shape[-1])


def parallel_conv_mla(h, positions, w_in, sc_kernel, q_norm, w_uq, kv_norm, w_ukv, w_out):
    b, s, _ = h.shape
    proj = h @ w_in
    cuts = [SC_WIDTH, 2 * SC_WIDTH, 3 * SC_WIDTH,
            3 * SC_WIDTH + MLA_Q_RANK, 3 * SC_WIDTH + MLA_Q_RANK + MLA_KV_RANK]
    gate_b, gate_c, xs, q_lat, kv_lat, k_rope = jnp.split(proj, cuts, axis=-1)

    y_a = gate_b * depthwise_conv(gate_c * xs, sc_kernel)

    q = (rms_norm(q_lat, q_norm) @ w_uq).reshape(b, s, MLA_HEADS, MLA_NOPE + MLA_ROPE)
    q_nope, q_pe = q[..., :MLA_NOPE], q[..., MLA_NOPE:]
    kv = (rms_norm(kv_lat, kv_norm) @ w_ukv).reshape(b, s, MLA_HEADS, MLA_NOPE + MLA_V)
    k_nope, v = kv[..., :MLA_NOPE], kv[..., MLA_NOPE:]
    half = MLA_ROPE // 2
    inv_freq = 1.0 / (ROPE_BASE ** (jnp.arange(half, dtype=jnp.float32) / half))
    ang = positions.astype(jnp.float32)[..., None] * inv_freq
    cos, sin = jnp.cos(ang), jnp.sin(ang)
    q_pe = apply_rope(q_pe, cos[:, :, None, :], sin[:, :, None, :])
    k_pe = apply_rope(k_rope, cos, sin)[:, :, None, :]
    q_full = jnp.concatenate([q_nope, q_pe], axis=-1)
    k_full = jnp.concatenate(
        [k_nope, jnp.broadcast_to(k_pe, (b, s, MLA_HEADS, MLA_ROPE))], axis=-1)
    y_b = block_attention(q_full, k_full, v)

    return jnp.concatenate([y_a, y_b], axis=-1) @ w_out


def conformer_conv(h, w_pw1, b_pw1, w_dw, b_dw, ln_g, ln_b, w_pw2, b_pw2):
    u = h @ w_pw1 + b_pw1
    a, g = jnp.split(u, 2, axis=-1)
    u = a * jax.nn.sigmoid(g)
    u = depthwise_conv(u, w_dw) + b_dw
    u = jax.nn.silu(layer_norm(u, ln_g, ln_b))
    return u @ w_pw2 + b_pw2


def squared_relu_mlp(h, w1, w2):
    return jnp.square(jax.nn.relu(h @ w1)) @ w2


def setup_inputs(seed: int = 0) -> dict:
    key = jax.random.key(seed)
    ks = jax.random.split(key, 24)

    def nrm(k, shape, fan_in):
        return jax.random.normal(k, shape, jnp.float32) * (fan_in ** -0.5)

    def gain(k, shape):
        return 1.0 + 0.05 * jax.random.normal(k, shape, jnp.float32)

    def bias(k, shape):
        return 0.02 * jax.random.normal(k, shape, jnp.float32)

    x = jax.random.normal(ks[0], (BATCH, SEQ, D_MODEL), jnp.float32)
    offsets = jax.random.randint(ks[1], (BATCH, 1), 0, SEQ, dtype=jnp.int32)
    positions = jnp.arange(SEQ, dtype=jnp.int32)[None, :] + offsets
    return {
        "x": x,
        "positions": positions,
        "sandwich_gains": gain(ks[2], (DEPTH, 4, D_MODEL)),
        "even_w_in": nrm(ks[3], (N_EVEN, D_MODEL, IN_COLS), D_MODEL),
        "even_sc_kernel": nrm(ks[4], (N_EVEN, SC_KERNEL, SC_WIDTH), SC_KERNEL),
        "even_q_norm": gain(ks[5], (N_EVEN, MLA_Q_RANK)),
        "even_w_uq": nrm(ks[6], (N_EVEN, MLA_Q_RANK, MLA_HEADS * (MLA_NOPE + MLA_ROPE)), MLA_Q_RANK),
        "even_kv_norm": gain(ks[7], (N_EVEN, MLA_KV_RANK)),
        "even_w_ukv": nrm(ks[8], (N_EVEN, MLA_KV_RANK, MLA_HEADS * (MLA_NOPE + MLA_V)), MLA_KV_RANK),
        "even_w_out": nrm(ks[9], (N_EVEN, MIX_WIDTH, D_MODEL), MIX_WIDTH),
        "odd_w_pw1": nrm(ks[10], (N_ODD, D_MODEL, 2 * CONF_WIDTH), D_MODEL),
        "odd_b_pw1": bias(ks[11], (N_ODD, 2 * CONF_WIDTH)),
        "odd_w_dw": nrm(ks[12], (N_ODD, CONF_KERNEL, CONF_WIDTH), CONF_KERNEL),
        "odd_b_dw": bias(ks[13], (N_ODD, CONF_WIDTH)),
        "odd_ln_g": gain(ks[14], (N_ODD, CONF_WIDTH)),
        "odd_ln_b": bias(ks[15], (N_ODD, CONF_WIDTH)),
        "odd_w_pw2": nrm(ks[16], (N_ODD, CONF_WIDTH, D_MODEL), CONF_WIDTH),
        "odd_b_pw2": bias(ks[17], (N_ODD, D_MODEL)),
        "mlp_w1": nrm(ks[18], (DEPTH, D_MODEL, D_FF), D_MODEL),
        "mlp_w2": nrm(ks[19], (DEPTH, D_FF, D_MODEL), D_FF),
    }


def reference(x, positions, sandwich_gains, even_w_in, even_sc_kernel, even_q_norm,
              even_w_uq, even_kv_norm, even_w_ukv, even_w_out, odd_w_pw1, odd_b_pw1,
              odd_w_dw, odd_b_dw, odd_ln_g, odd_ln_b, odd_w_pw2, odd_b_pw2,
              mlp_w1, mlp_w2):
    for i in range(DEPTH):
        g = sandwich_gains[i]
        j = i // 2
        h = rms_norm(x, g[0])
        if i % 2 == 0:
            m = parallel_conv_mla(h, positions, even_w_in[j], even_sc_kernel[j],
                                  even_q_norm[j], even_w_uq[j], even_kv_norm[j],
                                  even_w_ukv[j], even_w_out[j])
        else:
            m = conformer_conv(h, odd_w_pw1[j], odd_b_pw1[j], odd_w_dw[j], odd_b_dw[j],
                               odd_ln_g[j], odd_ln_b[j], odd_w_pw2[j], odd_b_pw2[j])
        x = x + rms_norm(m, g[1])
        h = rms_norm(x, g[2])
        x = x + rms_norm(squared_relu_mlp(h, mlp_w1[i], mlp_w2[i]), g[3])
    return x
```

```cpp
#include <hip/hip_runtime.h>
#include <hip/hip_bf16.h>
#include <hip/hip_cooperative_groups.h>
#include <cstdio>
#include <cstdint>
#include <cmath>
namespace cg = cooperative_groups;
namespace pg8 {
#define PG8_LAS __attribute__((address_space(3)))
typedef unsigned short bf16_t;
typedef short bf16x8 __attribute__((ext_vector_type(8)));
typedef float f32x4 __attribute__((ext_vector_type(4)));
typedef unsigned u32x4 __attribute__((ext_vector_type(4)));
constexpr int BM = 256, BK = 64, HALF = 128, HTB = HALF * BK * 2  , STAGE_BYTES = 8 * HTB, NXCD = 8, WGM = 8;

__host__ __device__ __forceinline__ int lds_byte(int r, int c) { const int st = (r >> 4) * 2 + (c >> 5), rr = r & 15, cc = c & 31, ob = rr * 64 + cc * 2; return st * 1024 + (ob ^ (((ob >> 9) & 1) << 5)); }
__host__ __device__ __forceinline__ void stage_rc(int b, int& R, int& C) { const int st = b / 1024, sb = b % 1024, swz = sb ^ (((sb >> 9) & 1) << 5); R = (st >> 1) * 16 + swz / 64; C = (st & 1) * 32 + (swz % 64) / 2; }
__host__ __device__ __forceinline__ int perm32(int rho) { const int n = rho >> 4, i = rho & 15; return 8 * (i >> 2) + 4 * n + (i & 3); }

struct Unit { int pm, pn; };
struct Gemm { const bf16_t* A; const bf16_t* Bt; int M, N, K, lda; };

struct StaticOrder {
    int nM, nN, nwg, G, c, flip;
    __host__ __device__ void init(int M, int N, int G_, int c_, int flip_ = 0) { nM = M / BM; nN = N / BM; nwg = nM * nN; G = G_; c = c_; flip = flip_; }
    __host__ __device__ bool next(int i, Unit& u) const {
        const long L = (long)i * G + c; if (L >= nwg) return false;
        int wgid = (int)L; { const int q = nwg / NXCD, r = nwg % NXCD, xcd = wgid % NXCD, off = wgid / NXCD; wgid = (xcd < r ? xcd * (q + 1) : r * (q + 1) + (xcd - r) * q) + off; }
        const int nig = WGM * nN, gid = wgid / nig, fm = gid * WGM, gsz = (nM - fm) < WGM ? (nM - fm) : WGM;
        u.pm = fm + ((wgid % nig) % gsz); u.pn = (wgid % nig) / gsz; if (flip) u.pm = nM - 1 - u.pm; return true;
    }
    __device__ __forceinline__ void a_ready(const Unit&) const {}
    __device__ __forceinline__ void done(const Unit&) const {}
};

__device__ __forceinline__ unsigned cvt_pk_bf16(float lo, float hi) { unsigned r; asm volatile("v_cvt_pk_bf16_f32 %0, %1, %2" : "=v"(r) : "v"(lo), "v"(hi)); return r; }
typedef float f32x2 __attribute__((ext_vector_type(2)));
__device__ __forceinline__ void st8(bf16_t* p, f32x4 v0, f32x4 v1) {
    u32x4 w; w.x = cvt_pk_bf16(v0[0], v0[1]); w.y = cvt_pk_bf16(v0[2], v0[3]); w.z = cvt_pk_bf16(v1[0], v1[1]); w.w = cvt_pk_bf16(v1[2], v1[3]); *(u32x4*)p = w;
}
template <int ACT  > struct EpiPlain {
    static constexpr bool PERM = true, AFTER_DRAIN = false;
    bf16_t* O; int ldc; const float* bias; const float* rs;
    __device__ __forceinline__ void operator()(const f32x4 (&acc)[2][2][4][2], const Unit& u, int wr, int wc, int fr, int fq) const {
        const int row0 = u.pm * BM + wr * 64 + fr, col0 = u.pn * BM + wc * 32 + 8 * fq;
        f32x4 bv[2][2];
#pragma unroll
        for (int bj = 0; bj < 2; ++bj)
#pragma unroll
            for (int n = 0; n < 2; ++n) bv[bj][n] = bias ? *(const f32x4*)(bias + col0 + bj * HALF + 4 * n) : (f32x4){0.f, 0.f, 0.f, 0.f};
#pragma unroll
        for (int ai = 0; ai < 2; ++ai)
#pragma unroll
            for (int m = 0; m < 4; ++m) { bf16_t* rowp = O + (size_t)(row0 + ai * HALF + m * 16) * ldc + col0; const float r = rs ? rs[row0 + ai * HALF + m * 16] : 1.f;
#pragma unroll
                for (int bj = 0; bj < 2; ++bj) { f32x4 v0 = acc[ai][bj][m][0] * r + bv[bj][0], v1 = acc[ai][bj][m][1] * r + bv[bj][1];
                    if (ACT == 1) {
#pragma unroll
                        for (int j = 0; j < 4; ++j) { const float a = fmaxf(v0[j], 0.f), b = fmaxf(v1[j], 0.f); v0[j] = a * a; v1[j] = b * b; } }
                    st8(rowp + bj * HALF, v0, v1); } }
    }
};
struct EpiInProj {
    static constexpr bool PERM = true, AFTER_DRAIN = false;
    bf16_t* O; int ldc; float* SS; const float* rs;
    __device__ __forceinline__ void operator()(const f32x4 (&acc)[2][2][4][2], const Unit& u, int wr, int wc, int fr, int fq) const {
        const int row0 = u.pm * BM + wr * 64 + fr, col0 = u.pn * BM + wc * 32 + 8 * fq;
#pragma unroll
        for (int ai = 0; ai < 2; ++ai)
#pragma unroll
            for (int m = 0; m < 4; ++m) { const int row = row0 + ai * HALF + m * 16; bf16_t* rowp = O + (size_t)row * ldc + col0; const float r = rs[row];
#pragma unroll
                for (int bj = 0; bj < 2; ++bj) { const f32x4 a = acc[ai][bj][m][0] * r, b = acc[ai][bj][m][1] * r; st8(rowp + bj * HALF, a, b);
                    const int grp = 8 * u.pn + 4 * bj + wc - 48;
                    if (grp >= 0 && grp < 20) {
                        float s = (a[0] * a[0] + a[1] * a[1]) + (a[2] * a[2] + a[3] * a[3]) + (b[0] * b[0] + b[1] * b[1]) + (b[2] * b[2] + b[3] * b[3]);
                        s += __shfl_xor(s, 16); s += __shfl_xor(s, 32);
                        if (fq == 0) SS[(size_t)row * 32 + grp] = s; } } }
    }
};
struct EpiRowScale {
    static constexpr bool PERM = true, AFTER_DRAIN = false;
    bf16_t* O; int ldc; const float* SS; int g0, ng4; float invk, eps;
    unsigned* km;
    __device__ __forceinline__ void operator()(const f32x4 (&acc)[2][2][4][2], const Unit& u, int wr, int wc, int fr, int fq) const {
        const int row0 = u.pm * BM + wr * 64 + fr, col0 = u.pn * BM + wc * 32 + 8 * fq;
        float mx[2] = {0.f, 0.f};
#pragma unroll
        for (int ai = 0; ai < 2; ++ai)
#pragma unroll
            for (int m = 0; m < 4; ++m) { const int row = row0 + ai * HALF + m * 16; const f32x4* sp = (const f32x4*)(SS + (size_t)row * 32) + g0;
                float s = 0.f; for (int t = 0; t < ng4; ++t) { const f32x4 v = sp[t]; s += (v[0] + v[1]) + (v[2] + v[3]); }
                const float r = rsqrtf(s * invk + eps);
                bf16_t* rowp = O + (size_t)row * ldc + col0;
#pragma unroll
                for (int bj = 0; bj < 2; ++bj) { const f32x4 a = acc[ai][bj][m][0] * r, b = acc[ai][bj][m][1] * r; st8(rowp + bj * HALF, a, b);
                    if (km && wc < 2) { float q = (a[0] * a[0] + a[1] * a[1]) + (a[2] * a[2] + a[3] * a[3]) + (b[0] * b[0] + b[1] * b[1]) + (b[2] * b[2] + b[3] * b[3]);
                        q += __shfl_xor(q, 16); q += __shfl_xor(q, 32); mx[bj] = fmaxf(mx[bj], q); } } }
        if (km && wc < 2) {
#pragma unroll
            for (int bj = 0; bj < 2; ++bj) { float v = mx[bj];
#pragma unroll
                for (int o = 1; o < 16; o <<= 1) v = fmaxf(v, __shfl_xor(v, o));
                if (fr == 0 && fq == 0) __hip_atomic_fetch_max(km + ((u.pm >> 5) * 8 + 2 * u.pn + bj) * 4 + wc, __float_as_uint(v), __ATOMIC_RELAXED, __HIP_MEMORY_SCOPE_AGENT); }
        }
    }
};
struct EpiGLU {
    static constexpr bool PERM = true, AFTER_DRAIN = false;
    bf16_t* O; int ldc; const float* bias; const float* rs;
    __device__ __forceinline__ void operator()(const f32x4 (&acc)[2][2][4][2], const Unit& u, int wr, int wc, int fr, int fq) const {
        const int row0 = u.pm * BM + wr * 64 + fr, ch0 = u.pn * HALF + wc * 32 + 8 * fq;
        f32x4 ba[2], bg[2];
#pragma unroll
        for (int n = 0; n < 2; ++n) { ba[n] = *(const f32x4*)(bias + ch0 + 4 * n); bg[n] = *(const f32x4*)(bias + 1024 + ch0 + 4 * n); }
#pragma unroll
        for (int ai = 0; ai < 2; ++ai)
#pragma unroll
            for (int m = 0; m < 4; ++m) { f32x4 o[2]; const float r = rs[row0 + ai * HALF + m * 16];
#pragma unroll
                for (int n = 0; n < 2; ++n) { const f32x4 a = acc[ai][0][m][n] * r + ba[n], g = acc[ai][1][m][n] * r + bg[n];
#pragma unroll
                    for (int j = 0; j < 4; ++j) o[n][j] = a[j] * __builtin_amdgcn_rcpf(1.f + __builtin_amdgcn_exp2f(-1.4426950408889634f * g[j])); }
                st8(O + (size_t)(row0 + ai * HALF + m * 16) * ldc + ch0, o[0], o[1]); }
    }
};

template <class Epi, class Sched, bool ALIGN_EPI = false, bool SP2 = false>
__device__ __forceinline__ void gemm_phase(PG8_LAS unsigned char* lds, const Gemm g, const Sched& S, const Epi& E) {
    const int tid = threadIdx.x, wid = __builtin_amdgcn_readfirstlane(tid >> 6), lane = tid & 63, wr = wid >> 2, wc = wid & 3, fr = lane & 15, fq = lane >> 4;
    const int K = g.K, nt = K / BK;
    unsigned voffA[2], voffB[2];
#pragma unroll
    for (int i = 0; i < 2; ++i) { int R, C; stage_rc(tid * 16 + i * 8192, R, C); const int Rb = Epi::PERM ? ((R & ~31) + perm32(R & 31)) : R;
        voffA[i] = (unsigned)(R * g.lda + C) * 2u; voffB[i] = (unsigned)(Rb * K + C) * 2u; }
    const size_t kstep = (size_t)(BK * 2);
    const size_t hstepA = (size_t)HALF * g.lda * 2, hstepB = (size_t)HALF * K * 2;
    const size_t tstepA = 2 * hstepA, tstepB = 2 * hstepB;
    const unsigned ldsw = (unsigned)wid * 1024u;
    const int aoff = lds_byte(wr * 64 + fr, fq * 8), boff = lds_byte(wc * 32 + fr, fq * 8);
#define PG8_SA(b, h) (((b) * 2 + (h)) * HTB)
#define PG8_SB(b, h) ((4 + (b) * 2 + (h)) * HTB)
#define PG8_STAGE(bufoff, gbase, voff) do { _Pragma("unroll") for (int _i = 0; _i < 2; ++_i) \
        __builtin_amdgcn_global_load_lds((const unsigned*)((const char*)(gbase) + (voff)[_i]), (PG8_LAS unsigned*)(lds + (bufoff) + ldsw + _i * 8192), 16, 0, 0); } while (0)
#define PG8_LDA(dst, b, h) do { _Pragma("unroll") for (int m = 0; m < 4; ++m) _Pragma("unroll") for (int k = 0; k < 2; ++k) dst[m][k] = *(const PG8_LAS bf16x8*)(lds + PG8_SA(b, h) + aoff + m * 2048 + k * 1024); } while (0)
#define PG8_LDB(dst, b, h) do { _Pragma("unroll") for (int n = 0; n < 2; ++n) _Pragma("unroll") for (int k = 0; k < 2; ++k) dst[n][k] = *(const PG8_LAS bf16x8*)(lds + PG8_SB(b, h) + boff + n * 2048 + k * 1024); } while (0)
#define PG8_MMA(ai, bj, At, Bt) do { __builtin_amdgcn_s_setprio(1); _Pragma("unroll") for (int m = 0; m < 4; ++m) _Pragma("unroll") for (int n = 0; n < 2; ++n) _Pragma("unroll") for (int k = 0; k < 2; ++k) \
        acc[ai][bj][m][n] = __builtin_amdgcn_mfma_f32_16x16x32_bf16(Bt[n][k], At[m][k], acc[ai][bj][m][n], 0, 0, 0); __builtin_amdgcn_s_setprio(0); } while (0)
#define PG8_WAIT_V(n) asm volatile("s_waitcnt vmcnt(" #n ")" ::: "memory")
#define PG8_WAIT_L(n) asm volatile("s_waitcnt lgkmcnt(" #n ")" ::: "memory")
#define PG8_BAR __builtin_amdgcn_s_barrier()
#define PG8_SCHED __builtin_amdgcn_sched_barrier(0)
    Unit cur, nxt; int ui = 0;
    if (!S.next(0, cur)) return;
    f32x4 acc[2][2][4][2];
#pragma unroll
    for (int a = 0; a < 2; ++a)
#pragma unroll
        for (int b = 0; b < 2; ++b)
#pragma unroll
            for (int m = 0; m < 4; ++m)
#pragma unroll
                for (int n = 0; n < 2; ++n) acc[a][b][m][n] = (f32x4){0.f, 0.f, 0.f, 0.f};
    bf16x8 At[4][2], B0[2][2], B1[2][2];
    const char* cA = (const char*)g.A + (size_t)cur.pm * tstepA; const char* cB = (const char*)g.Bt + (size_t)cur.pn * tstepB;
    S.a_ready(cur);
    if constexpr (SP2) {
        PG8_STAGE(PG8_SB(0, 0), cB, voffB); PG8_STAGE(PG8_SB(0, 1), cB + hstepB, voffB); PG8_STAGE(PG8_SA(0, 0), cA, voffA); PG8_STAGE(PG8_SA(0, 1), cA + hstepA, voffA);
        if (wr == 1) PG8_BAR;
        PG8_WAIT_V(2); PG8_BAR;
        PG8_STAGE(PG8_SB(1, 0), cB + kstep, voffB); PG8_STAGE(PG8_SA(1, 0), cA + kstep, voffA); PG8_STAGE(PG8_SB(1, 1), cB + hstepB + kstep, voffB);
        PG8_WAIT_V(6); PG8_BAR;
    } else {
        PG8_STAGE(PG8_SB(0, 0), cB, voffB); PG8_STAGE(PG8_SA(0, 0), cA, voffA); PG8_STAGE(PG8_SB(0, 1), cB + hstepB, voffB); PG8_STAGE(PG8_SA(0, 1), cA + hstepA, voffA);
        if (wr == 1) PG8_BAR;
        PG8_WAIT_V(4); PG8_BAR;
        PG8_STAGE(PG8_SB(1, 0), cB + kstep, voffB); PG8_STAGE(PG8_SA(1, 0), cA + kstep, voffA); PG8_STAGE(PG8_SB(1, 1), cB + hstepB + kstep, voffB);
        PG8_WAIT_V(6); PG8_BAR;
    }
    for (;;) {
        const bool has_next = S.next(ui + 1, nxt);
        const char* nA = has_next ? (const char*)g.A + (size_t)nxt.pm * tstepA : cA; const char* nB = has_next ? (const char*)g.Bt + (size_t)nxt.pn * tstepB : cB;
        for (int t = 0; t < nt; t += 2) {
            const bool last = (t == nt - 2);
            const char* a1 = cA + (size_t)(t + 1) * kstep;
            const char* a2 = last ? nA : cA + (size_t)(t + 2) * kstep; const char* b2 = last ? nB : cB + (size_t)(t + 2) * kstep;
            const char* a3 = a2 + kstep; const char* b3 = b2 + kstep;
            if (last && has_next) S.a_ready(nxt);
            if constexpr (SP2) {
            PG8_LDB(B0, 0, 0); PG8_LDB(B1, 0, 1); PG8_SCHED; PG8_LDA(At, 0, 0); PG8_STAGE(PG8_SA(1, 1), a1 + hstepA, voffA);
            PG8_WAIT_V(8); PG8_WAIT_L(0); PG8_BAR; PG8_MMA(0, 0, At, B0); PG8_MMA(0, 1, At, B1); PG8_BAR; PG8_SCHED;
            PG8_LDA(At, 0, 1); PG8_STAGE(PG8_SB(0, 0), b2, voffB); PG8_STAGE(PG8_SB(0, 1), b2 + hstepB, voffB); PG8_STAGE(PG8_SA(0, 0), a2, voffA);
            PG8_WAIT_V(8); PG8_WAIT_L(0); PG8_BAR; PG8_MMA(1, 0, At, B0); PG8_MMA(1, 1, At, B1); PG8_BAR; PG8_SCHED;
            PG8_LDB(B0, 1, 0); PG8_LDB(B1, 1, 1); PG8_SCHED; PG8_LDA(At, 1, 0); PG8_STAGE(PG8_SA(0, 1), a2 + hstepA, voffA);
            PG8_WAIT_V(8); PG8_WAIT_L(0); PG8_BAR; PG8_MMA(0, 0, At, B0); PG8_MMA(0, 1, At, B1); PG8_BAR; PG8_SCHED;
            PG8_LDA(At, 1, 1); PG8_STAGE(PG8_SB(1, 0), b3, voffB); PG8_STAGE(PG8_SB(1, 1), b3 + hstepB, voffB); PG8_STAGE(PG8_SA(1, 0), a3, voffA);
            PG8_WAIT_V(8); PG8_WAIT_L(0); PG8_BAR; PG8_MMA(1, 0, At, B0); PG8_MMA(1, 1, At, B1); PG8_BAR; PG8_SCHED;
            } else {
            PG8_LDB(B0, 0, 0); PG8_SCHED; PG8_LDA(At, 0, 0); PG8_STAGE(PG8_SA(1, 1), a1 + hstepA, voffA);
            PG8_WAIT_L(8); PG8_BAR; PG8_WAIT_L(0); PG8_MMA(0, 0, At, B0); PG8_BAR; PG8_SCHED;
            PG8_LDB(B1, 0, 1); PG8_STAGE(PG8_SB(0, 0), b2, voffB);
            PG8_BAR; PG8_WAIT_L(0); PG8_MMA(0, 1, At, B1); PG8_BAR;
            PG8_LDA(At, 0, 1); PG8_STAGE(PG8_SA(0, 0), a2, voffA);
            PG8_BAR; PG8_WAIT_L(0); PG8_MMA(1, 0, At, B0); PG8_BAR; PG8_SCHED;
            PG8_STAGE(PG8_SB(0, 1), b2 + hstepB, voffB);
            PG8_WAIT_V(6); PG8_BAR; PG8_MMA(1, 1, At, B1); PG8_BAR;
            PG8_LDB(B0, 1, 0); PG8_SCHED; PG8_LDA(At, 1, 0); PG8_STAGE(PG8_SA(0, 1), a2 + hstepA, voffA);
            PG8_WAIT_L(8); PG8_BAR; PG8_WAIT_L(0); PG8_MMA(0, 0, At, B0); PG8_BAR; PG8_SCHED;
            PG8_LDB(B1, 1, 1); PG8_STAGE(PG8_SB(1, 0), b3, voffB);
            PG8_BAR; PG8_WAIT_L(0); PG8_MMA(0, 1, At, B1); PG8_BAR;
            PG8_LDA(At, 1, 1); PG8_STAGE(PG8_SA(1, 0), a3, voffA);
            PG8_BAR; PG8_WAIT_L(0); PG8_MMA(1, 0, At, B0); PG8_BAR; PG8_SCHED;
            PG8_STAGE(PG8_SB(1, 1), b3 + hstepB, voffB);
            PG8_WAIT_V(6); PG8_BAR; PG8_MMA(1, 1, At, B1); PG8_BAR;
            }
        }
        if constexpr (ALIGN_EPI) { if (wr == 0) PG8_BAR; }
        if constexpr (!Epi::AFTER_DRAIN) { E(acc, cur, wr, wc, fr, fq); S.done(cur); }
        if (!has_next) break;
#pragma unroll
        for (int a = 0; a < 2; ++a)
#pragma unroll
            for (int b = 0; b < 2; ++b)
#pragma unroll
                for (int m = 0; m < 4; ++m)
#pragma unroll
                    for (int n = 0; n < 2; ++n) acc[a][b][m][n] = (f32x4){0.f, 0.f, 0.f, 0.f};
        cur = nxt; cA = nA; cB = nB; ++ui;
        if constexpr (ALIGN_EPI) { if (wr == 1) PG8_BAR; }
    }
    PG8_WAIT_V(0);
    if constexpr (!ALIGN_EPI) { if (wr == 0) PG8_BAR; }
    PG8_BAR;
    if constexpr (Epi::AFTER_DRAIN) { E.fused(acc, cur, wr, wc, fr, fq, lds, wid, lane); S.done(cur); }
#undef PG8_SA
#undef PG8_SB
#undef PG8_STAGE
#undef PG8_LDA
#undef PG8_LDB
#undef PG8_MMA
#undef PG8_WAIT_V
#undef PG8_WAIT_L
#undef PG8_BAR
#undef PG8_SCHED
}
}
namespace att {
using bf16x8 = __attribute__((ext_vector_type(8))) short;
using s16x4  = __attribute__((ext_vector_type(4))) short;
using f32x16 = __attribute__((ext_vector_type(16))) float;
using f32x8  = __attribute__((ext_vector_type(8))) float;
using u32x4  = __attribute__((ext_vector_type(4))) unsigned;
typedef unsigned short bf16_t;
constexpr int NW = 8, QBLK = 32, KVBLK = 64, SEQ = 8192, NHEAD = 8;
constexpr int LDQ = 768, LDKV = 1024, LDPE = 32, LDO = 1024;
constexpr float SCALE = 0.10206207261596575f;
constexpr int SHM_K = KVBLK * 256, SHM_V = KVBLK * 64 * 2;
#define KSWZ(row, colB) ((row) * 256 + ((colB) ^ (((row) & 15) << 4)))
#define SBAR() __builtin_amdgcn_sched_barrier(0)
__device__ __forceinline__ int crow(int r, int hi) { return (r & 3) + 8 * (r >> 2) + 4 * hi; }
__device__ __forceinline__ unsigned cvtpk(float lo, float hi) { unsigned r; asm volatile("v_cvt_pk_bf16_f32 %0, %1, %2" : "=v"(r) : "v"(lo), "v"(hi)); return r; }
__device__ __forceinline__ float bf2f(short v) { return __uint_as_float(((unsigned)(unsigned short)v) << 16); }
__device__ __forceinline__ bf16x8 ld8(const bf16_t* p) { return *reinterpret_cast<const bf16x8*>(p); }

__device__ __forceinline__ void partialSM(f32x16& p0) {
#pragma unroll
  for (int r = 0; r < 16; ++r) p0[r] = __builtin_amdgcn_exp2f(p0[r]);
}
__device__ __forceinline__ void finishSM(f32x16& p0, f32x16& p1, float& l_reg, bf16x8& pa0, bf16x8& pa1, bf16x8& pa2, bf16x8& pa3) {
#pragma unroll
  for (int r = 0; r < 16; ++r) p1[r] = __builtin_amdgcn_exp2f(p1[r]);
  float ps = 0;
#pragma unroll
  for (int r = 0; r < 16; ++r) ps += p0[r];
#pragma unroll
  for (int r = 0; r < 16; ++r) ps += p1[r];
  { auto rr = __builtin_amdgcn_permlane32_swap(__float_as_uint(ps), __float_as_uint(ps), false, false);
    ps = __uint_as_float(rr[0]) + __uint_as_float(rr[1]); }
  l_reg += ps;
#define PK4(P, BASE, OUT) do { u32x4 w = {cvtpk(P[BASE + 0], P[BASE + 1]), cvtpk(P[BASE + 2], P[BASE + 3]), cvtpk(P[BASE + 4], P[BASE + 5]), cvtpk(P[BASE + 6], P[BASE + 7])}; \
    OUT = *reinterpret_cast<bf16x8*>(&w); } while (0)
  PK4(p0, 0, pa0); PK4(p0, 8, pa1); PK4(p1, 0, pa2); PK4(p1, 8, pa3);
#undef PK4
}
__device__ __forceinline__ void qkt(f32x16& p0, f32x16& p1, const char* Ks, const bf16x8* qr, const f32x16& negm, int r32, int hi) {
#pragma unroll
  for (int d0 = 0; d0 < 6; ++d0) { int cb = (d0 * 16 + hi * 8) * 2;
    bf16x8 b0 = *reinterpret_cast<const bf16x8*>(Ks + KSWZ(r32, cb));
    bf16x8 b1 = *reinterpret_cast<const bf16x8*>(Ks + KSWZ(32 + r32, cb));
    if (d0 == 0) { p0 = __builtin_amdgcn_mfma_f32_32x32x16_bf16(b0, qr[0], negm, 0, 0, 0); p1 = __builtin_amdgcn_mfma_f32_32x32x16_bf16(b1, qr[0], negm, 0, 0, 0); }
    else { p0 = __builtin_amdgcn_mfma_f32_32x32x16_bf16(b0, qr[d0], p0, 0, 0, 0); p1 = __builtin_amdgcn_mfma_f32_32x32x16_bf16(b1, qr[d0], p1, 0, 0, 0); } }
}
__device__ __forceinline__ int v_st(int k, int c) { const int kk = (k & ~0xC) | ((k & 4) << 1) | ((k & 8) >> 1); return ((kk >> 3) * 2 + (c >> 5)) * 512 + ((kk & 7) * 32 + (c & 31)) * 2; }
__device__ __forceinline__ int v_rd_base(int lane) { return ((lane & 3) << 3) | (((lane >> 2) & 3) << 6) | (((lane >> 4) & 1) << 5) | (((lane >> 5) & 1) << 8); }
constexpr int v_rd_off(int d0, int ks, int half) { return d0 * 512 + ks * 2048 + half * 1024; }
template <int OFF> __device__ __forceinline__ s16x4 tr_read(int vb) {
  s16x4 r; asm volatile("ds_read_b64_tr_b16 %0, %1 offset:%2" : "=&v"(r) : "v"(vb), "i"(OFF) : "memory"); return r;
}
template <int D0> __device__ __forceinline__ void pv_one(f32x16& od, int vb, bf16x8 pa0, bf16x8 pa1, bf16x8 pa2, bf16x8 pa3) {
  const s16x4 l0 = tr_read<v_rd_off(D0, 0, 0)>(vb), h0 = tr_read<v_rd_off(D0, 0, 1)>(vb), l1 = tr_read<v_rd_off(D0, 1, 0)>(vb), h1 = tr_read<v_rd_off(D0, 1, 1)>(vb);
  const s16x4 l2 = tr_read<v_rd_off(D0, 2, 0)>(vb), h2 = tr_read<v_rd_off(D0, 2, 1)>(vb), l3 = tr_read<v_rd_off(D0, 3, 0)>(vb), h3 = tr_read<v_rd_off(D0, 3, 1)>(vb);
  asm volatile("s_waitcnt lgkmcnt(0)" ::: "memory"); SBAR();
#define PK(L, H) (bf16x8){L[0], L[1], L[2], L[3], H[0], H[1], H[2], H[3]}
  od = __builtin_amdgcn_mfma_f32_32x32x16_bf16(pa0, PK(l0, h0), od, 0, 0, 0);
  od = __builtin_amdgcn_mfma_f32_32x32x16_bf16(pa1, PK(l1, h1), od, 0, 0, 0);
  od = __builtin_amdgcn_mfma_f32_32x32x16_bf16(pa2, PK(l2, h2), od, 0, 0, 0);
  od = __builtin_amdgcn_mfma_f32_32x32x16_bf16(pa3, PK(l3, h3), od, 0, 0, 0);
#undef PK
}
__device__ __forceinline__ void pv_d0(f32x16* o, int vb, bf16x8 pa0, bf16x8 pa1, bf16x8 pa2, bf16x8 pa3) {
  pv_one<0>(o[0], vb, pa0, pa1, pa2, pa3); pv_one<1>(o[1], vb, pa0, pa1, pa2, pa3);
}
struct VF4 { s16x4 l0, h0, l1, h1; };
__device__ __forceinline__ void pv_load_a(VF4& f, int vb) {
  f.l0 = tr_read<v_rd_off(0, 0, 0)>(vb); f.h0 = tr_read<v_rd_off(0, 0, 1)>(vb); f.l1 = tr_read<v_rd_off(1, 0, 0)>(vb); f.h1 = tr_read<v_rd_off(1, 0, 1)>(vb);
}
__device__ __forceinline__ void pv_all(f32x16* o, const VF4& f, int vb, bf16x8 pa0, bf16x8 pa1, bf16x8 pa2, bf16x8 pa3, f32x16& pn) {
#define EX4(B) do { pn[B] = __builtin_amdgcn_exp2f(pn[B]); pn[B + 1] = __builtin_amdgcn_exp2f(pn[B + 1]); pn[B + 2] = __builtin_amdgcn_exp2f(pn[B + 2]); pn[B + 3] = __builtin_amdgcn_exp2f(pn[B + 3]); } while (0)
#define PK(L, H) (bf16x8){L[0], L[1], L[2], L[3], H[0], H[1], H[2], H[3]}
  const s16x4 b0l = tr_read<v_rd_off(0, 1, 0)>(vb), b0h = tr_read<v_rd_off(0, 1, 1)>(vb), b1l = tr_read<v_rd_off(1, 1, 0)>(vb), b1h = tr_read<v_rd_off(1, 1, 1)>(vb);
  const s16x4 c0l = tr_read<v_rd_off(0, 2, 0)>(vb), c0h = tr_read<v_rd_off(0, 2, 1)>(vb), c1l = tr_read<v_rd_off(1, 2, 0)>(vb), c1h = tr_read<v_rd_off(1, 2, 1)>(vb);
  asm volatile("s_waitcnt lgkmcnt(8)" ::: "memory"); SBAR();
  o[0] = __builtin_amdgcn_mfma_f32_32x32x16_bf16(pa0, PK(f.l0, f.h0), o[0], 0, 0, 0);
  o[1] = __builtin_amdgcn_mfma_f32_32x32x16_bf16(pa0, PK(f.l1, f.h1), o[1], 0, 0, 0);
  EX4(0); SBAR();
  const s16x4 d0l = tr_read<v_rd_off(0, 3, 0)>(vb), d0h = tr_read<v_rd_off(0, 3, 1)>(vb), d1l = tr_read<v_rd_off(1, 3, 0)>(vb), d1h = tr_read<v_rd_off(1, 3, 1)>(vb);
  asm volatile("s_waitcnt lgkmcnt(8)" ::: "memory"); SBAR();
  o[0] = __builtin_amdgcn_mfma_f32_32x32x16_bf16(pa1, PK(b0l, b0h), o[0], 0, 0, 0);
  o[1] = __builtin_amdgcn_mfma_f32_32x32x16_bf16(pa1, PK(b1l, b1h), o[1], 0, 0, 0);
  EX4(4); SBAR(); asm volatile("s_waitcnt lgkmcnt(4)" ::: "memory"); SBAR();
  o[0] = __builtin_amdgcn_mfma_f32_32x32x16_bf16(pa2, PK(c0l, c0h), o[0], 0, 0, 0);
  o[1] = __builtin_amdgcn_mfma_f32_32x32x16_bf16(pa2, PK(c1l, c1h), o[1], 0, 0, 0);
  EX4(8); SBAR(); asm volatile("s_waitcnt lgkmcnt(0)" ::: "memory"); SBAR();
  o[0] = __builtin_amdgcn_mfma_f32_32x32x16_bf16(pa3, PK(d0l, d0h), o[0], 0, 0, 0);
  o[1] = __builtin_amdgcn_mfma_f32_32x32x16_bf16(pa3, PK(d1l, d1h), o[1], 0, 0, 0);
  EX4(12);
#undef PK
#undef EX4
}
__device__ __forceinline__ void glds16(const void* gsrc, unsigned lds_dst) { unsigned keep;
  asm volatile("s_mov_b32 %0, m0\n\ts_mov_b32 m0, %2\n\ts_nop 0\n\tglobal_load_lds_dwordx4 %1, off\n\ts_mov_b32 m0, %0" : "=&s"(keep) : "v"(gsrc), "s"(lds_dst) : "memory"); }
#define WAIT_BAR(N) asm volatile("s_waitcnt vmcnt(" #N ") lgkmcnt(0)\n\ts_barrier" ::: "memory")
constexpr int RING_K = 0, RING_V = 3 * SHM_K, RING_WS = RING_V + 3 * SHM_V, ATT_LDS = RING_WS + NW * 64 * 4;

__device__ __forceinline__ void attn_unit(const bf16_t* __restrict__ Qb, const bf16_t* __restrict__ KVh, const bf16_t* __restrict__ PEb, const float* __restrict__ CSq,
                                          bf16_t* __restrict__ Ob, char* lds, float kmax) {
  const int tid = threadIdx.x, lane = tid & 63, r32 = lane & 31, hi = lane >> 5; const int wid = __builtin_amdgcn_readfirstlane(tid >> 6);
  char* V_lds = lds + RING_V; char* K_lds = lds + RING_K;
  float* ws = (float*)(lds + RING_WS) + wid * 64; float* li_l = ws; float* al_l = ws + 32;
  const unsigned lds0 = (unsigned)(uintptr_t)lds;
  const char* ksrc0; const char* ksrc1; unsigned kstride;
  { const int rr = lane >> 4, cp = lane & 15;
    const int r0 = 8 * wid + rr, c0 = cp ^ (r0 & 15), r1 = r0 + 4, c1 = cp ^ (r1 & 15);
    ksrc0 = (c0 < 8) ? (const char*)(KVh + (long)r0 * LDKV + c0 * 8) : (const char*)(PEb + (long)r0 * LDPE + (c0 & 3) * 8);
    ksrc1 = (c1 < 8) ? (const char*)(KVh + (long)r1 * LDKV + c1 * 8) : (const char*)(PEb + (long)r1 * LDPE + (c1 & 3) * 8);
    kstride = 0; }
  unsigned kst0, kst1;
  { const int cp = lane & 15, rr = lane >> 4; const int c0 = cp ^ ((8 * wid + rr) & 15), c1 = cp ^ ((8 * wid + rr + 4) & 15);
    kst0 = (c0 < 8) ? KVBLK * LDKV * 2 : KVBLK * LDPE * 2; kst1 = (c1 < 8) ? KVBLK * LDKV * 2 : KVBLK * LDPE * 2; }
  (void)kstride;
  const char* vsrc;
  { const int kk = 8 * wid + ((lane & 31) >> 2), k = kk, col = (lane >> 5) * 32 + (lane & 3) * 8;
    vsrc = (const char*)(KVh + (long)k * LDKV + 64 + col); }
  const unsigned kdst = lds0 + RING_K + wid * 2048, vdst = lds0 + RING_V + wid * 1024;
#define DMA_K(slot) do { glds16(ksrc0, (unsigned)__builtin_amdgcn_readfirstlane(kdst + (slot) * SHM_K)); glds16(ksrc1, (unsigned)__builtin_amdgcn_readfirstlane(kdst + (slot) * SHM_K + 1024)); \
    ksrc0 += kst0; ksrc1 += kst1; } while (0)
#define DMA_V(slot) do { glds16(vsrc, (unsigned)__builtin_amdgcn_readfirstlane(vdst + (slot) * SHM_V)); vsrc += KVBLK * LDKV * 2; } while (0)
  DMA_K(0); DMA_V(0); DMA_K(1);
  float l_reg = 0; f32x16 o[2] = {}; bf16x8 qr[6]; f32x16 negm;
  const bf16_t* Qw = Qb + (long)(wid * QBLK + r32) * LDQ + hi * 8;
#pragma unroll
  for (int d0 = 0; d0 < 6; ++d0) qr[d0] = ld8(Qw + d0 * 16);
  {
    const float* cs = CSq + (long)(wid * QBLK + r32) * 32 + hi * 8;
    const f32x8 c = *reinterpret_cast<const f32x8*>(cs), s = *reinterpret_cast<const f32x8*>(cs + 16);
    constexpr float QC = SCALE * 1.4426950408889634f;
    float y1[8], y2[8];
#pragma unroll
    for (int j = 0; j < 8; ++j) { const float x1 = bf2f(qr[4][j]) * QC, x2 = bf2f(qr[5][j]) * QC; y1[j] = x1 * c[j] - x2 * s[j]; y2[j] = x2 * c[j] + x1 * s[j]; }
#pragma unroll
    for (int d0 = 0; d0 < 4; ++d0) { float z[8];
#pragma unroll
      for (int j = 0; j < 8; ++j) z[j] = bf2f(qr[d0][j]) * QC;
      u32x4 wz = {cvtpk(z[0], z[1]), cvtpk(z[2], z[3]), cvtpk(z[4], z[5]), cvtpk(z[6], z[7])}; qr[d0] = *reinterpret_cast<bf16x8*>(&wz); }
    u32x4 w1 = {cvtpk(y1[0], y1[1]), cvtpk(y1[2], y1[3]), cvtpk(y1[4], y1[5]), cvtpk(y1[6], y1[7])};
    u32x4 w2 = {cvtpk(y2[0], y2[1]), cvtpk(y2[2], y2[3]), cvtpk(y2[4], y2[5]), cvtpk(y2[6], y2[7])};
    qr[4] = *reinterpret_cast<bf16x8*>(&w1); qr[5] = *reinterpret_cast<bf16x8*>(&w2);
  }
  { float q2 = 0.f;
#pragma unroll
    for (int d0 = 0; d0 < 6; ++d0)
#pragma unroll
      for (int j = 0; j < 8; ++j) { const float t = bf2f(qr[d0][j]); q2 = fmaf(t, t, q2); }
    auto rr = __builtin_amdgcn_permlane32_swap(__float_as_uint(q2), __float_as_uint(q2), false, false);
    const float bref = sqrtf(__uint_as_float(rr[0]) + __uint_as_float(rr[1])) * kmax;
#pragma unroll
    for (int r = 0; r < 16; ++r) negm[r] = -bref; }
  const int vb0 = (int)(uintptr_t)V_lds + v_rd_base(lane);
  f32x16 pA0, pA1, pB0, pB1; bf16x8 pa0, pa1, pa2, pa3; constexpr int NT = SEQ / KVBLK;
  int s_prev = 2, s_cur = 0, s_next = 1;
#define ROT() do { const int t_ = s_prev; s_prev = s_cur; s_cur = s_next; s_next = t_; } while (0)
  WAIT_BAR(0);
  DMA_K(2); DMA_V(1);
  qkt(pA0, pA1, K_lds, qr, negm, r32, hi); partialSM(pA0);
  ROT();
#define ITER(PN0, PN1, PP0, PP1, GK, GV) do { \
    if (GK) DMA_K(s_prev); if (GV) DMA_V(s_next); \
    VF4 vf_; pv_load_a(vf_, vb0 + s_prev * SHM_V);         \
    SBAR(); qkt(PN0, PN1, K_lds + s_cur * SHM_K, qr, negm, r32, hi); \
    finishSM(PP0, PP1, l_reg, pa0, pa1, pa2, pa3); SBAR(); \
    pv_all(o, vf_, vb0 + s_prev * SHM_V, pa0, pa1, pa2, pa3, PN0); asm volatile("" : "+v"(PN0)); SBAR(); \
    ROT(); } while (0)
  for (int j = 1; j + 2 < NT; j += 2) {
    WAIT_BAR(3); ITER(pB0, pB1, pA0, pA1, true, true);
    WAIT_BAR(3); ITER(pA0, pA1, pB0, pB1, (j + 3 < NT), true);
  }
  WAIT_BAR(0); ITER(pB0, pB1, pA0, pA1, false, false);
  finishSM(pB0, pB1, l_reg, pa0, pa1, pa2, pa3); SBAR();
  pv_d0(o, vb0 + s_prev * SHM_V, pa0, pa1, pa2, pa3);
  if (hi == 0) li_l[r32] = l_reg; asm volatile("s_waitcnt lgkmcnt(0)" ::: "memory");
  float rli[16];
#pragma unroll
  for (int r = 0; r < 16; ++r) rli[r] = __builtin_amdgcn_rcpf(li_l[crow(r, hi)]);
  bf16_t* Ow = Ob + (long)(wid * QBLK) * LDO;
#pragma unroll
  for (int r = 0; r < 16; ++r) { const int orow = crow(r, hi);
#pragma unroll
    for (int d0 = 0; d0 < 2; ++d0) { const unsigned w = cvtpk(o[d0][r] * rli[r], 0.f); Ow[(long)orow * LDO + d0 * 32 + r32] = (bf16_t)(w & 0xffffu); } }
  asm volatile("s_waitcnt lgkmcnt(0)\n\ts_barrier" ::: "memory");
#undef DMA_K
#undef DMA_V
#undef ITER
#undef ROT
}
#undef WAIT_BAR
#undef KSWZ
#undef SBAR
}

constexpr int NWAVES = 8, NTHR = NWAVES * 64;
constexpr int BATCH = 4, SEQ = 8192, D = 1024, M = BATCH * SEQ, FF = 4096;
constexpr int INC = 2208, INP = 2304;
constexpr int QR = 384, KVR = 256, NQ = 768, NKV = 1024;
constexpr float EPS = 1e-6f;
#ifndef MK_PER_PHASE
#define MK_PER_PHASE 0
#endif
constexpr int N_PHASES = 16;
#ifndef PROBE_PHASE
#define PROBE_PHASE -1
#endif

constexpr size_t MiB = 1u << 20;
constexpr size_t WS_WIN = 1 * MiB;
constexpr size_t WS_WUQ = 6 * MiB;
constexpr size_t WS_WUKV = 7 * MiB;
constexpr size_t WS_WOUT = 8 * MiB;
constexpr size_t WS_WPW1 = 10 * MiB;
constexpr size_t WS_WPW2 = 14 * MiB;
constexpr size_t WS_W1 = 16 * MiB;
constexpr size_t WS_W2 = 32 * MiB;
constexpr size_t WS_CS = 48 * MiB;
constexpr size_t WS_KPE = 52 * MiB;
constexpr size_t WS_RS = 54 * MiB;
constexpr size_t WS_SS = 56 * MiB;
constexpr size_t WS_XN = 64 * MiB;
constexpr size_t WS_MO = 128 * MiB;
constexpr size_t WS_U = 192 * MiB;
constexpr size_t WS_PROJ = 192 * MiB;
constexpr size_t WS_Q = 336 * MiB;
constexpr size_t WS_KV = 384 * MiB;
constexpr size_t WS_G = 192 * MiB;
constexpr size_t WS_C = 256 * MiB;
constexpr size_t WS_MIX = 448 * MiB;
constexpr size_t WS_END = 512 * MiB;

constexpr int LDS_BYTES = 135168;

#define LAS __attribute__((address_space(3)))
typedef unsigned short bf16;
typedef unsigned v4u __attribute__((ext_vector_type(4)));
typedef unsigned v2u __attribute__((ext_vector_type(2)));
typedef float f32x4 __attribute__((ext_vector_type(4)));
typedef float f32x2 __attribute__((ext_vector_type(2)));
typedef short bf16x8 __attribute__((ext_vector_type(8)));
__device__ __forceinline__ unsigned pk2(float lo, float hi) { return pg8::cvt_pk_bf16(lo, hi); }
__device__ __forceinline__ float bflo(unsigned w) { return __uint_as_float(w << 16); }
__device__ __forceinline__ float bfhi(unsigned w) { return __uint_as_float(w & 0xffff0000u); }
__device__ __forceinline__ float wave_sum(float v) {
#pragma unroll
    for (int o = 1; o < 64; o <<= 1) v += __shfl_xor(v, o);
    return v;
}
template <int CTRL> __device__ __forceinline__ float dpp_get(float v) { return __int_as_float(__builtin_amdgcn_update_dpp(0, __float_as_int(v), CTRL, 0xf, 0xf, false)); }
__device__ __forceinline__ float wave_sum_dpp(float v) {
    v += dpp_get<0xB1>(v);
    v += dpp_get<0x4E>(v);
    v += dpp_get<0x141>(v);
    v += dpp_get<0x140>(v);
    { auto rr = __builtin_amdgcn_permlane16_swap(__float_as_uint(v), __float_as_uint(v), false, false); v = __uint_as_float(rr[0]) + __uint_as_float(rr[1]); }
    { auto rr = __builtin_amdgcn_permlane32_swap(__float_as_uint(v), __float_as_uint(v), false, false); v = __uint_as_float(rr[0]) + __uint_as_float(rr[1]); }
    return v;
}


#define XB_TMO      128
#define XB_XCNT(j)  (256  + 64 * (j))
#define XB_XSUB(j)  (1280 + 64 * (j))
#define XB_XGEN(j)  (2304 + 64 * (j))
#define XB_TOP      3328
#define XB_TOPGEN   3392
#define XCD_BAR_WORDS 3456
#define XB_SPIN_CAP (1u << 18)

__device__ __forceinline__ unsigned xb_ld(unsigned* p)              { return __hip_atomic_load(p, __ATOMIC_RELAXED, __HIP_MEMORY_SCOPE_AGENT); }
__device__ __forceinline__ unsigned xb_add(unsigned* p, unsigned v) { return __hip_atomic_fetch_add(p, v, __ATOMIC_RELAXED, __HIP_MEMORY_SCOPE_AGENT); }
__device__ __forceinline__ unsigned xb_xcc_id() { return (unsigned)__builtin_amdgcn_s_getreg((3 << 11) | 20) & 0xFu; }
#define XB_SPIN(cond, bar) do { unsigned _sp = 0; while (cond) { \
    if ((++_sp & 255u) == 0u) { if (xb_ld(&(bar)[XB_TMO])) break; if (_sp > XB_SPIN_CAP) { atomicAdd(&(bar)[XB_TMO], 1u); break; } } } } while (0)

struct XcdBarrier {
    unsigned* bar; unsigned x;
    volatile LAS unsigned* st;
};

__device__ __forceinline__ XcdBarrier xcd_barrier_post(unsigned* bar, volatile LAS unsigned* st) {
    XcdBarrier b; b.bar = bar; b.x = xb_xcc_id(); b.st = st;
    if (threadIdx.x == 0) (void)xb_add(&bar[XB_XCNT(b.x)], 1u);
    return b;
}
__device__ __forceinline__ void xcd_barrier_complete(unsigned* bar, unsigned x, unsigned& nloc, unsigned& nx) {
    const unsigned G = gridDim.x * gridDim.y * gridDim.z;
    unsigned sum, cnt, mine, sp = 0u;
    for (;;) {
        sum = 0u; cnt = 0u; mine = 0u;
#pragma unroll
        for (unsigned j = 0; j < 16; ++j) { const unsigned c = xb_ld(&bar[XB_XCNT(j)]); sum += c; cnt += (c > 0u) ? 1u : 0u; mine = (j == x) ? c : mine; }
        if (sum == G) break;
        __builtin_amdgcn_s_sleep(1);
        if ((++sp & 255u) == 0u) { if (xb_ld(&bar[XB_TMO])) break; if (sp > XB_SPIN_CAP) { atomicAdd(&bar[XB_TMO], 1u); break; } }
    }
    nloc = mine > 0u ? mine : 1u; nx = cnt > 0u ? cnt : 1u;
}

__device__ __forceinline__ void xcd_barrier(const XcdBarrier& b) {
    asm volatile("s_waitcnt vmcnt(0)" ::: "memory");
    __syncthreads();
    if (threadIdx.x == 0) {
        unsigned* bar = b.bar;
        __builtin_amdgcn_s_waitcnt(0);
        unsigned nloc = b.st[0], nx = b.st[1];
        if (nloc == 0u) { xcd_barrier_complete(bar, b.x, nloc, nx); b.st[0] = nloc; b.st[1] = nx; }
        const unsigned old = xb_add(&bar[XB_XSUB(b.x)], 1u);
        const unsigned gen = old / nloc;
        if (old + 1u == (gen + 1u) * nloc) {
            __builtin_amdgcn_fence(__ATOMIC_RELEASE, "agent");
            asm volatile("s_waitcnt vmcnt(0)" ::: "memory");
            const unsigned og = xb_add(&bar[XB_TOP], 1u);
            const unsigned tg = og / nx;
            if (og + 1u == (tg + 1u) * nx) __hip_atomic_store(&bar[XB_TOPGEN], tg + 1u, __ATOMIC_RELAXED, __HIP_MEMORY_SCOPE_AGENT);
            else XB_SPIN(xb_ld(&bar[XB_TOPGEN]) == tg, bar);
            __hip_atomic_store(&bar[XB_XGEN(b.x)], gen + 1u, __ATOMIC_RELAXED, __HIP_MEMORY_SCOPE_AGENT);
            __builtin_amdgcn_fence(__ATOMIC_ACQUIRE, "agent");
            asm volatile("s_waitcnt vmcnt(0)" ::: "memory");
        } else {
            XB_SPIN(xb_ld(&bar[XB_XGEN(b.x)]) == gen, bar);
            __builtin_amdgcn_fence(__ATOMIC_ACQUIRE, "agent");
            asm volatile("s_waitcnt vmcnt(0)" ::: "memory");
        }
    }
    __syncthreads();
}

constexpr int CW_BAR = 4096;
constexpr int CW_KMAX = 7680;
constexpr int MISC_OFF = 131072 + 320;
struct Args { const float* in[20]; float* out; unsigned char* ws; int ph_lo, ph_hi; };

__device__ __forceinline__ void transpose_item(const float* __restrict__ W, int K, int N, bf16* __restrict__ WT, int mode, const float* __restrict__ gk, LAS float* scr, int item, int lane) {
    const int nblk = N / 32, kb = item / nblk, nb = item % nblk, k0 = 64 * kb, n0 = 32 * nb;
#pragma unroll
    for (int i = 0; i < 8; ++i) { const int kk = 8 * i + (lane >> 3), c4 = (lane & 7) * 4;
        f32x4 v = *(const f32x4*)(W + (size_t)(k0 + kk) * N + n0 + c4); if (gk) v = v * gk[k0 + kk];
        scr[kk * 33 + c4 + 0] = v[0]; scr[kk * 33 + c4 + 1] = v[1]; scr[kk * 33 + c4 + 2] = v[2]; scr[kk * 33 + c4 + 3] = v[3]; }
    asm volatile("s_waitcnt lgkmcnt(0)" ::: "memory");
    int r0 = n0; if (mode == 1) { const int half = n0 >> 10, ch = n0 & 1023; r0 = 256 * (ch >> 7) + 128 * half + (ch & 127); }
    const int c = lane & 7;
#pragma unroll
    for (int j = 0; j < 4; ++j) { const int n = (lane >> 3) + 8 * j; const LAS float* s = scr + (8 * c) * 33 + n;
        v4u o; o.x = pk2(s[0 * 33], s[1 * 33]); o.y = pk2(s[2 * 33], s[3 * 33]); o.z = pk2(s[4 * 33], s[5 * 33]); o.w = pk2(s[6 * 33], s[7 * 33]);
        *(v4u*)(WT + (size_t)(r0 + n) * K + k0 + 8 * c) = o; }
    asm volatile("s_waitcnt lgkmcnt(0)" ::: "memory");
}

template <bool XIN_F32, bool HAS_MO, bool OUT_F32>
__device__ __forceinline__ void norm_phase(int gw, int NGW, int lane, const float* __restrict__ xf, const bf16* xb_in, const bf16* __restrict__ mo, const float* __restrict__ gpost,
                                           float* __restrict__ outf, bf16* xb_out, float* __restrict__ rs) {
    f32x4 gp[4];
#pragma unroll
    for (int j = 0; j < 4; ++j) gp[j] = HAS_MO ? *((const f32x4*)gpost + lane + 64 * j) : (f32x4){0.f, 0.f, 0.f, 0.f};
    for (int m = gw; m < M; m += NGW) {
        f32x4 v[4];
        if (XIN_F32) { const f32x4* xr = (const f32x4*)(xf + (size_t)m * D) + lane;
#pragma unroll
            for (int j = 0; j < 4; ++j) v[j] = xr[64 * j]; }
        else { const v2u* xr = (const v2u*)(xb_in + (size_t)m * D) + lane;
#pragma unroll
            for (int j = 0; j < 4; ++j) { const v2u w = xr[64 * j]; v[j] = (f32x4){bflo(w.x), bfhi(w.x), bflo(w.y), bfhi(w.y)}; } }
        if (HAS_MO) {
            const v2u* mr = (const v2u*)(mo + (size_t)m * D) + lane; f32x4 mv[4]; float ss = 0.f;
#pragma unroll
            for (int j = 0; j < 4; ++j) { const v2u w = mr[64 * j]; mv[j] = (f32x4){bflo(w.x), bfhi(w.x), bflo(w.y), bfhi(w.y)};
                ss += (mv[j][0] * mv[j][0] + mv[j][1] * mv[j][1]) + (mv[j][2] * mv[j][2] + mv[j][3] * mv[j][3]); }
            const float r = rsqrtf(wave_sum_dpp(ss) * (1.f / D) + EPS);
#pragma unroll
            for (int j = 0; j < 4; ++j) v[j] = v[j] + mv[j] * r * gp[j];
        }
        if (OUT_F32) { f32x4* xo = (f32x4*)(outf + (size_t)m * D) + lane;
#pragma unroll
            for (int j = 0; j < 4; ++j) xo[64 * j] = v[j]; }
        else { float s2 = 0.f;
#pragma unroll
            for (int j = 0; j < 4; ++j) s2 += (v[j][0] * v[j][0] + v[j][1] * v[j][1]) + (v[j][2] * v[j][2] + v[j][3] * v[j][3]);
            const float r2 = rsqrtf(wave_sum_dpp(s2) * (1.f / D) + EPS);
            if (lane == 0) rs[m] = r2;
            v2u* o8 = (v2u*)(xb_out + (size_t)m * D) + lane;
#pragma unroll
            for (int j = 0; j < 4; ++j) { v2u w; w.x = pk2(v[j][0], v[j][1]); w.y = pk2(v[j][2], v[j][3]); o8[64 * j] = w; } }
    }
}

__device__ __forceinline__ void conv_phase(int G, LAS float* red, const bf16* __restrict__ Gin, const float* __restrict__ wdw, const float* __restrict__ bdw,
                                           const float* __restrict__ lng, const float* __restrict__ lnb, bf16* __restrict__ Cout) {
    constexpr int GT = 16, WN = GT + 30, NG = 128 / GT, NS = 2 * GT;
    const int tid = threadIdx.x, lane = tid & 63, wave = tid >> 6, ch = 2 * tid;
    LAS f32x2* wl = (LAS f32x2*)(red + 2 * 8 * NS);
#pragma unroll
    for (int k = 0; k < 31; ++k) wl[k * NTHR + tid] = *(const f32x2*)(wdw + k * 1024 + ch);
    const f32x2 bb = *(const f32x2*)(bdw + ch), gg = *(const f32x2*)(lng + ch), lb = *(const f32x2*)(lnb + ch);
    const char* gbase = (const char*)Gin; const unsigned voff = (unsigned)tid * 4u;
    for (int strip = blockIdx.x; strip < M / 128; strip += G) {
        const int tb = strip * 128, sb = tb & (SEQ - 1);
        unsigned wnd[WN], nxt[GT];
#pragma unroll
        for (int i = 0; i < WN; ++i) { const int sl = sb - 15 + i; const bool ok = (sl >= 0 && sl < SEQ);
            const int row = __builtin_amdgcn_readfirstlane(ok ? tb - 15 + i : tb);
            const unsigned v = *(const unsigned*)(gbase + (size_t)row * (D * 2) + voff); wnd[i] = ok ? v : 0u; }
#pragma unroll 1
        for (int g = 0; g < NG; ++g) {
            const int t0 = tb + GT * g;
#pragma unroll
            for (int i = 0; i < GT; ++i) { const int sl = sb + GT * g + GT + 15 + i; const bool ok = (sl < SEQ) && (g < NG - 1);
                const int row = __builtin_amdgcn_readfirstlane(ok ? t0 + GT + 15 + i : tb);
                const unsigned v = *(const unsigned*)(gbase + (size_t)row * (D * 2) + voff); nxt[i] = ok ? v : 0u; }
            f32x2 acc[GT];
#pragma unroll
            for (int j = 0; j < GT; ++j) acc[j] = bb;
#pragma unroll
            for (int k = 0; k < 31; ++k) { const f32x2 w = wl[k * NTHR + tid];
#pragma unroll
                for (int j = 0; j < GT; ++j) { const f32x2 xx = {bflo(wnd[j + k]), bfhi(wnd[j + k])}; acc[j] = w * xx + acc[j]; } }
            LAS float* rb = red + (g & 1) * (8 * NS);
#pragma unroll
            for (int j = 0; j < GT; ++j) { const float s = wave_sum_dpp(acc[j].x + acc[j].y), q = wave_sum_dpp(acc[j].x * acc[j].x + acc[j].y * acc[j].y);
                if (lane == 0) { rb[j * 8 + wave] = s; rb[(GT + j) * 8 + wave] = q; } }
            __syncthreads();
#pragma unroll
            for (int j = 0; j < GT; ++j) { const f32x4 s0 = *(const LAS f32x4*)(rb + j * 8), s1 = *(const LAS f32x4*)(rb + j * 8 + 4), q0 = *(const LAS f32x4*)(rb + (GT + j) * 8), q1 = *(const LAS f32x4*)(rb + (GT + j) * 8 + 4);
                const float ts = ((s0[0] + s0[1]) + (s0[2] + s0[3])) + ((s1[0] + s1[1]) + (s1[2] + s1[3])), tq = ((q0[0] + q0[1]) + (q0[2] + q0[3])) + ((q1[0] + q1[1]) + (q1[2] + q1[3]));
                const float mu = ts * (1.f / D), var = fmaxf(tq * (1.f / D) - mu * mu, 0.f), rstd = rsqrtf(var + EPS);
                float y0 = (acc[j].x - mu) * rstd * gg.x + lb.x, y1 = (acc[j].y - mu) * rstd * gg.y + lb.y;
                y0 = y0 * __builtin_amdgcn_rcpf(1.f + __builtin_amdgcn_exp2f(-1.4426950408889634f * y0)); y1 = y1 * __builtin_amdgcn_rcpf(1.f + __builtin_amdgcn_exp2f(-1.4426950408889634f * y1));
                *(unsigned*)(Cout + (size_t)(t0 + j) * D + ch) = pk2(y0, y1); }
#pragma unroll
            for (int i = 0; i < 30; ++i) wnd[i] = wnd[i + GT];
#pragma unroll
            for (int i = 0; i < GT; ++i) wnd[30 + i] = nxt[i];
        }
    }
}

__global__ void __launch_bounds__(NTHR, 2) fwd_megakernel(Args args) {
    extern __shared__ __attribute__((aligned(16))) unsigned char lds[];
    cg::grid_group grid = cg::this_grid();
    LAS unsigned char* ldsl = (LAS unsigned char*)lds;
    const int tid = threadIdx.x, lane = tid & 63, wave = __builtin_amdgcn_readfirstlane(tid >> 6);
    const int G = gridDim.x, bx = blockIdx.x, vcu = (G % 8 == 0) ? (bx % 8) * (G / 8) + bx / 8 : bx;
    const int gw = vcu * NWAVES + wave, NGW = G * NWAVES;
    const int gt = bx * NTHR + tid, NGT = G * NTHR;
    unsigned char* ws = args.ws;
    const float* x = args.in[0]; const int* positions = (const int*)args.in[1]; const float* gains = args.in[2];
    float* out = args.out;
    bf16 *Win_t = (bf16*)(ws + WS_WIN), *Wuq_t = (bf16*)(ws + WS_WUQ), *Wukv_t = (bf16*)(ws + WS_WUKV), *Wout_t = (bf16*)(ws + WS_WOUT), *Wpw1_t = (bf16*)(ws + WS_WPW1),
         *Wpw2_t = (bf16*)(ws + WS_WPW2), *W1_t = (bf16*)(ws + WS_W1), *W2_t = (bf16*)(ws + WS_W2);
    float* CS = (float*)(ws + WS_CS); bf16* KPE = (bf16*)(ws + WS_KPE); float* SS = (float*)(ws + WS_SS); float* RS = (float*)(ws + WS_RS);
    bf16 *XN = (bf16*)(ws + WS_XN), *MO = (bf16*)(ws + WS_MO), *U = (bf16*)(ws + WS_U), *PROJ = (bf16*)(ws + WS_PROJ), *Q = (bf16*)(ws + WS_Q), *KV = (bf16*)(ws + WS_KV),
         *GB = (bf16*)(ws + WS_G), *CB = (bf16*)(ws + WS_C), *MIX = (bf16*)(ws + WS_MIX);
    const int lo = args.ph_lo, hi = args.ph_hi;
    volatile LAS unsigned* MISC = (volatile LAS unsigned*)(ldsl + MISC_OFF);
    if (tid < 32) MISC[tid] = 0u;
    __syncthreads();
    if (lo > hi) grid.sync();
    XcdBarrier bar; bar.bar = (unsigned*)ws + CW_BAR; bar.x = 0; bar.st = nullptr;
    if (hi - lo > 1) bar = xcd_barrier_post((unsigned*)ws + CW_BAR, MISC + 8);
#ifdef ONLY_PHASE
#define IN(k) ((k) == ONLY_PHASE)
#else
#define IN(k) (lo <= (k) && (k) < hi)
#endif
#define REPS(k) _Pragma("unroll") for (int rep_ = 0; rep_ < ((k) == PROBE_PHASE ? 2 : 1); ++rep_)
#define SEAM(k) do { if (IN(k) && IN((k) + 1)) xcd_barrier(bar); } while (0)

    if (IN(0)) REPS(0) {
        LAS float* scr = (LAS float*)(ldsl + wave * 16384);
        constexpr int I_IN = (D / 64) * (INC / 32), I_UQ = (QR / 64) * (NQ / 32), I_UKV = (KVR / 64) * (NKV / 32), I_OUT = (D / 64) * (D / 32), I_PW1 = (D / 64) * (2048 / 32), I_PW2 = I_OUT,
                      I_1 = (D / 64) * (FF / 32), I_2 = (FF / 64) * (D / 32);
        constexpr int NITEMS = I_IN + I_UQ + I_UKV + I_OUT + I_PW1 + I_PW2 + 2 * I_1 + 2 * I_2;
        for (int it = gw; it < NITEMS; it += NGW) {
            int r = it;
            if (r < I_IN) { transpose_item(args.in[3], D, INC, Win_t, 0, gains + 0 * D, scr, r, lane); continue; } r -= I_IN;
            if (r < I_UQ) { transpose_item(args.in[6], QR, NQ, Wuq_t, 0, args.in[5], scr, r, lane); continue; } r -= I_UQ;
            if (r < I_UKV) { transpose_item(args.in[8], KVR, NKV, Wukv_t, 0, args.in[7], scr, r, lane); continue; } r -= I_UKV;
            if (r < I_OUT) { transpose_item(args.in[9], D, D, Wout_t, 0, nullptr, scr, r, lane); continue; } r -= I_OUT;
            if (r < I_PW1) { transpose_item(args.in[10], D, 2048, Wpw1_t, 1, gains + 4 * D, scr, r, lane); continue; } r -= I_PW1;
            if (r < I_PW2) { transpose_item(args.in[16], D, D, Wpw2_t, 0, nullptr, scr, r, lane); continue; } r -= I_PW2;
            if (r < 2 * I_1) { const int l = r / I_1; transpose_item(args.in[18] + (size_t)l * D * FF, D, FF, W1_t + (size_t)l * D * FF, 0, gains + (4 * l + 2) * D, scr, r - l * I_1, lane); continue; } r -= 2 * I_1;
            { const int l = r / I_2; transpose_item(args.in[19] + (size_t)l * D * FF, FF, D, W2_t + (size_t)l * D * FF, 0, nullptr, scr, r - l * I_2, lane); }
        }
        for (int i = gt; i < (INP - INC) * D / 8; i += NGT) *((v4u*)(Win_t + (size_t)INC * D) + i) = (v4u){0u, 0u, 0u, 0u};
        for (int i = gt; i < M * 16; i += NGT) { const int tok = i >> 4, f = i & 15;
            const float inv = 1.0f / powf(10000.0f, (float)f * (1.0f / 16.0f)); const float ang = (float)positions[tok] * inv;
            CS[(size_t)tok * 32 + f] = cosf(ang); CS[(size_t)tok * 32 + 16 + f] = sinf(ang); }
        norm_phase<true, false, false>(gw, NGW, lane, x, nullptr, nullptr, nullptr, nullptr, XN, RS);
    }
    SEAM(0);
    if (IN(1)) REPS(1) {
        pg8::Gemm g{XN, Win_t, M, INP, D, D}; pg8::StaticOrder S; S.init(M, INP, G, bx);
        pg8::EpiInProj E{PROJ, INP, SS, RS};
        pg8::gemm_phase<pg8::EpiInProj, pg8::StaticOrder, true, true>(ldsl, g, S, E);
    }
    SEAM(1);
    if (IN(2)) REPS(2) {
        { pg8::Gemm g{PROJ + 1536, Wuq_t, M, NQ, QR, INP}; pg8::StaticOrder S; S.init(M, NQ, G, bx);
          pg8::EpiRowScale E{Q, NQ, SS, 0, 3, 1.f / QR, EPS, nullptr};
          pg8::gemm_phase<pg8::EpiRowScale, pg8::StaticOrder, true, true>(ldsl, g, S, E); }
        { pg8::Gemm g{PROJ + 1920, Wukv_t, M, NKV, KVR, INP}; pg8::StaticOrder S; S.init(M, NKV, G, bx);
          pg8::EpiRowScale E{KV, NKV, SS, 3, 2, 1.f / KVR, EPS, (unsigned*)ws + CW_KMAX};
          pg8::gemm_phase<pg8::EpiRowScale, pg8::StaticOrder, true, true>(ldsl, g, S, E); }
        const float* sck = args.in[4];
        const int nslot = (G == 256) ? 384 : G, slot0 = (G == 256 && bx >= 128) ? 128 + 2 * (bx - 128) : bx, myslots = (G == 256 && bx >= 128) ? 2 : 1;
        { const int c = (tid & 63) * 8;
          float wk[3][8];
#pragma unroll
          for (int k = 0; k < 3; ++k)
#pragma unroll
            for (int j = 0; j < 8; ++j) wk[k][j] = sck[k * 512 + c + j];
          const int mstep = nslot * (NTHR / 64);
          for (int sl = 0; sl < myslots; ++sl)
          for (int m0 = (slot0 + sl) * (NTHR / 64) + (tid >> 6); m0 < M; m0 += 2 * mstep) {
            bf16x8 gb[2], c0[2], c1[2], c2[2], x0[2], x1[2], x2[2]; int mm[2];
#pragma unroll
            for (int q = 0; q < 2; ++q) { const int m = (m0 + q * mstep < M) ? m0 + q * mstep : m0, s = m & (SEQ - 1); mm[q] = m;
                const bf16* p = PROJ + (size_t)m * INP; const bool okl = s > 0, okr = s < SEQ - 1;
                const bf16* pl = okl ? p - INP : p; const bf16* pr = okr ? p + INP : p;
                gb[q] = *(const bf16x8*)(p + c); c1[q] = *(const bf16x8*)(p + 512 + c); x1[q] = *(const bf16x8*)(p + 1024 + c);
                c0[q] = *(const bf16x8*)(pl + 512 + c); x0[q] = *(const bf16x8*)(pl + 1024 + c); c2[q] = *(const bf16x8*)(pr + 512 + c); x2[q] = *(const bf16x8*)(pr + 1024 + c);
                const bf16x8 zz = {0, 0, 0, 0, 0, 0, 0, 0}; if (!okl) c0[q] = zz; if (!okr) c2[q] = zz; }
#pragma unroll
            for (int q = 0; q < 2; ++q) if (q == 0 || m0 + mstep < M) { float y[8];
#pragma unroll
                for (int j = 0; j < 8; ++j) { const float u0 = att::bf2f(c0[q][j]) * att::bf2f(x0[q][j]), u1 = att::bf2f(c1[q][j]) * att::bf2f(x1[q][j]), u2 = att::bf2f(c2[q][j]) * att::bf2f(x2[q][j]);
                    y[j] = att::bf2f(gb[q][j]) * (wk[0][j] * u0 + wk[1][j] * u1 + wk[2][j] * u2); }
                v4u o; o.x = pk2(y[0], y[1]); o.y = pk2(y[2], y[3]); o.z = pk2(y[4], y[5]); o.w = pk2(y[6], y[7]);
                *(v4u*)(MIX + (size_t)mm[q] * D + c) = o; } } }
        float wq0 = 0.f, wq1 = 0.f, wq2 = 0.f, wq3 = 0.f;
        for (int it = gt; it < M * 16; it += NGT) { const int m = it >> 4, f = it & 15;
            const float x1 = bflo((unsigned)PROJ[(size_t)m * INP + 2176 + f]), x2 = bflo((unsigned)PROJ[(size_t)m * INP + 2192 + f]);
            const float c = CS[(size_t)m * 32 + f], sn = CS[(size_t)m * 32 + 16 + f];
            KPE[(size_t)m * 32 + f] = (bf16)(pk2(x1 * c - x2 * sn, 0.f) & 0xffffu); KPE[(size_t)m * 32 + 16 + f] = (bf16)(pk2(x2 * c + x1 * sn, 0.f) & 0xffffu);
            float q = x1 * x1 + x2 * x2;
            q += dpp_get<0xB1>(q); q += dpp_get<0x4E>(q); q += dpp_get<0x141>(q); q += dpp_get<0x140>(q);
            { auto rr = __builtin_amdgcn_permlane16_swap(__float_as_uint(q), __float_as_uint(q), false, false); q = fmaxf(__uint_as_float(rr[0]), __uint_as_float(rr[1])); }
            { auto rr = __builtin_amdgcn_permlane32_swap(__float_as_uint(q), __float_as_uint(q), false, false); q = fmaxf(__uint_as_float(rr[0]), __uint_as_float(rr[1])); }
            const int b = m >> 13;
            wq0 = (b == 0) ? fmaxf(wq0, q) : wq0; wq1 = (b == 1) ? fmaxf(wq1, q) : wq1; wq2 = (b == 2) ? fmaxf(wq2, q) : wq2; wq3 = (b == 3) ? fmaxf(wq3, q) : wq3; }
        {
            LAS float* wm = (LAS float*)ldsl;
            if (lane == 0) *(LAS f32x4*)(wm + wave * 4) = (f32x4){wq0, wq1, wq2, wq3};
            __syncthreads();
            if (tid < 4) { float v = wm[tid];
#pragma unroll
                for (int w = 1; w < 8; ++w) v = fmaxf(v, wm[w * 4 + tid]);
                __hip_atomic_fetch_max((unsigned*)ws + CW_KMAX + (tid * 8) * 4 + 3, __float_as_uint(v), __ATOMIC_RELAXED, __HIP_MEMORY_SCOPE_AGENT); }
            __syncthreads(); }
    }
    SEAM(2);
    if (IN(3)) REPS(3) {
        constexpr int NU = BATCH * 8 * (SEQ / 256);
        for (int u = vcu; u < NU; u += G) {
            const int unit = u;
            const int bh = unit >> 5, qb = unit & 31, b = bh >> 3, h = bh & 7; const size_t rowbase = (size_t)b * SEQ, q0 = (size_t)qb * 256;
            const unsigned* kmw = (const unsigned*)ws + CW_KMAX;
            const float kmax = sqrtf(__uint_as_float(kmw[bh * 4 + 0]) + __uint_as_float(kmw[bh * 4 + 1]) + __uint_as_float(kmw[(b * 8) * 4 + 3])) * 1.01f;
            att::attn_unit(Q + (rowbase + q0) * NQ + h * 96, KV + rowbase * NKV + h * 128, KPE + rowbase * 32, CS + (rowbase + q0) * 32,
                           MIX + (rowbase + q0) * D + 512 + h * 64, (char*)lds, kmax);
        }
    }
    SEAM(3);
    if (IN(4)) REPS(4) {
        pg8::Gemm g{MIX, Wout_t, M, D, D, D}; pg8::StaticOrder S; S.init(M, D, G, bx);
        pg8::EpiPlain<0> E{MO, D, nullptr, nullptr};
        pg8::gemm_phase<pg8::EpiPlain<0>, pg8::StaticOrder, true, true>(ldsl, g, S, E);
    }
    SEAM(4);
    if (IN(5)) REPS(5) norm_phase<false, true, false>(gw, NGW, lane, nullptr, XN, MO, gains + 1 * D, nullptr, XN, RS);
    SEAM(5);
    if (IN(6)) REPS(6) {
        pg8::Gemm g{XN, W1_t, M, FF, D, D}; pg8::StaticOrder S; S.init(M, FF, G, bx);
        pg8::EpiPlain<1> E{U, FF, nullptr, RS};
        pg8::gemm_phase<pg8::EpiPlain<1>, pg8::StaticOrder, true, true>(ldsl, g, S, E);
    }
    SEAM(6);
    if (IN(7)) REPS(7) {
        pg8::Gemm g{U, W2_t, M, D, FF, FF}; pg8::StaticOrder S; S.init(M, D, G, bx, 1);
        pg8::EpiPlain<0> E{MO, D, nullptr, nullptr};
        pg8::gemm_phase<pg8::EpiPlain<0>, pg8::StaticOrder, true, true>(ldsl, g, S, E);
    }
    SEAM(7);
    if (IN(8)) REPS(8) norm_phase<false, true, false>(gw, NGW, lane, nullptr, XN, MO, gains + 3 * D, nullptr, XN, RS);
    SEAM(8);
    if (IN(9)) REPS(9) {
        pg8::Gemm g{XN, Wpw1_t, M, 2048, D, D}; pg8::StaticOrder S; S.init(M, 2048, G, bx);
        pg8::EpiGLU E{GB, D, args.in[11], RS};
        pg8::gemm_phase<pg8::EpiGLU, pg8::StaticOrder, true, true>(ldsl, g, S, E);
    }
    SEAM(9);
    if (IN(10)) REPS(10) conv_phase(G, (LAS float*)ldsl, GB, args.in[12], args.in[13], args.in[14], args.in[15], CB);
    SEAM(10);
    if (IN(11)) REPS(11) {
        pg8::Gemm g{CB, Wpw2_t, M, D, D, D}; pg8::StaticOrder S; S.init(M, D, G, bx);
        pg8::EpiPlain<0> E{MO, D, args.in[17], nullptr};
        pg8::gemm_phase<pg8::EpiPlain<0>, pg8::StaticOrder, true, true>(ldsl, g, S, E);
    }
    SEAM(11);
    if (IN(12)) REPS(12) norm_phase<false, true, false>(gw, NGW, lane, nullptr, XN, MO, gains + 5 * D, nullptr, XN, RS);
    SEAM(12);
    if (IN(13)) REPS(13) {
        pg8::Gemm g{XN, W1_t + (size_t)D * FF, M, FF, D, D}; pg8::StaticOrder S; S.init(M, FF, G, bx);
        pg8::EpiPlain<1> E{U, FF, nullptr, RS};
        pg8::gemm_phase<pg8::EpiPlain<1>, pg8::StaticOrder, true, true>(ldsl, g, S, E);
    }
    SEAM(13);
    if (IN(14)) REPS(14) {
        pg8::Gemm g{U, W2_t + (size_t)D * FF, M, D, FF, FF}; pg8::StaticOrder S; S.init(M, D, G, bx, 1);
        pg8::EpiPlain<0> E{MO, D, nullptr, nullptr};
        pg8::gemm_phase<pg8::EpiPlain<0>, pg8::StaticOrder, true, true>(ldsl, g, S, E);
    }
    SEAM(14);
    if (IN(15)) REPS(15) norm_phase<false, true, true>(gw, NGW, lane, nullptr, XN, MO, gains + 7 * D, out, nullptr, nullptr);
#undef IN
#undef SEAM
}

extern "C" void kernel_launch(void* const* d_in, const int* in_sizes, int n_in, void* d_out, int out_size, void* d_ws, size_t ws_size, hipStream_t stream) {
    static int grid = 0;
    if (grid == 0) {
        if (n_in != 20 || in_sizes[0] != M * D || out_size != M * D || ws_size < WS_END) {
            fprintf(stderr, "kernel_launch: shape mismatch: n_in %d in0 %d out %d ws %zu (need %zu)\n", n_in, n_in > 0 ? in_sizes[0] : -1, out_size, ws_size, (size_t)WS_END); grid = -1; return; }
        int dev = 0, cus = 0, per_cu = 0;
        if (hipGetDevice(&dev) != hipSuccess || hipDeviceGetAttribute(&cus, hipDeviceAttributeMultiprocessorCount, dev) != hipSuccess) { grid = -1; return; }
        if (hipFuncSetAttribute((const void*)fwd_megakernel, hipFuncAttributeMaxDynamicSharedMemorySize, LDS_BYTES) != hipSuccess) { fprintf(stderr, "kernel_launch: hipFuncSetAttribute failed\n"); grid = -1; return; }
        if (hipOccupancyMaxActiveBlocksPerMultiprocessor(&per_cu, (const void*)fwd_megakernel, NTHR, LDS_BYTES) != hipSuccess || per_cu < 1) { fprintf(stderr, "kernel_launch: occupancy query says %d\n", per_cu); per_cu = 1; }
        (void)hipGetLastError();
        grid = cus;
    }
    if (grid < 0) return;
    if (hipMemsetAsync(d_ws, 0, 32768, stream) != hipSuccess) { fprintf(stderr, "kernel_launch: memset failed\n"); return; }
    Args a{};
    for (int i = 0; i < 20; ++i) a.in[i] = (const float*)d_in[i];
    a.out = (float*)d_out; a.ws = (unsigned char*)d_ws;
#if MK_PER_PHASE
    for (int p = 0; p < N_PHASES; ++p) { a.ph_lo = p; a.ph_hi = p + 1; hipLaunchKernelGGL(fwd_megakernel, dim3(grid), dim3(NTHR), LDS_BYTES, stream, a); }
#else
    a.ph_lo = 0; a.ph_hi = N_PHASES;
    void* kargs[] = {&a};
    hipError_t e = hipLaunchCooperativeKernel((const void*)fwd_megakernel, dim3(grid), dim3(NTHR), kargs, LDS_BYTES, stream);
    if (e != hipSuccess) fprintf(stderr, "kernel_launch: cooperative launch failed: %s (grid %d)\n", hipGetErrorString(e), grid);
#endif
}
```

```cpp
#include <hip/hip_runtime.h>
#include <hip/hip_bf16.h>
#include <hip/hip_cooperative_groups.h>
#include <cstdio>
#include <cstdint>
#include <cmath>
namespace cg = cooperative_groups;
namespace pg8 {
#define PG8_LAS __attribute__((address_space(3)))
typedef unsigned short bf16_t;
typedef short bf16x8 __attribute__((ext_vector_type(8)));
typedef float f32x4 __attribute__((ext_vector_type(4)));
typedef unsigned u32x4 __attribute__((ext_vector_type(4)));
constexpr int BM = 256, BK = 64, HALF = 128, HTB = HALF * BK * 2  , STAGE_BYTES = 8 * HTB, NXCD = 8, WGM = 8;

__host__ __device__ __forceinline__ int lds_byte(int r, int c) { const int st = (r >> 4) * 2 + (c >> 5), rr = r & 15, cc = c & 31, ob = rr * 64 + cc * 2; return st * 1024 + (ob ^ (((ob >> 9) & 1) << 5)); }
__host__ __device__ __forceinline__ void stage_rc(int b, int& R, int& C) { const int st = b / 1024, sb = b % 1024, swz = sb ^ (((sb >> 9) & 1) << 5); R = (st >> 1) * 16 + swz / 64; C = (st & 1) * 32 + (swz % 64) / 2; }
__host__ __device__ __forceinline__ int perm32(int rho) { const int n = rho >> 4, i = rho & 15; return 8 * (i >> 2) + 4 * n + (i & 3); }

struct Unit { int pm, pn; };
struct Gemm { const bf16_t* A; const bf16_t* Bt; int M, N, K, lda; };

struct StaticOrder {
    int nM, nN, nwg, G, c, flip;
    __host__ __device__ void init(int M, int N, int G_, int c_, int flip_ = 0) { nM = M / BM; nN = N / BM; nwg = nM * nN; G = G_; c = c_; flip = flip_; }
    __host__ __device__ bool next(int i, Unit& u) const {
        const long L = (long)i * G + c; if (L >= nwg) return false;
        int wgid = (int)L; { const int q = nwg / NXCD, r = nwg % NXCD, xcd = wgid % NXCD, off = wgid / NXCD; wgid = (xcd < r ? xcd * (q + 1) : r * (q + 1) + (xcd - r) * q) + off; }
        const int nig = WGM * nN, gid = wgid / nig, fm = gid * WGM, gsz = (nM - fm) < WGM ? (nM - fm) : WGM;
        u.pm = fm + ((wgid % nig) % gsz); u.pn = (wgid % nig) / gsz; if (flip) u.pm = nM - 1 - u.pm; return true;
    }
    __device__ __forceinline__ void a_ready(const Unit&) const {}
    __device__ __forceinline__ void done(const Unit&) const {}
};

__device__ __forceinline__ unsigned cvt_pk_bf16(float lo, float hi) { unsigned r; asm volatile("v_cvt_pk_bf16_f32 %0, %1, %2" : "=v"(r) : "v"(lo), "v"(hi)); return r; }
typedef float f32x2 __attribute__((ext_vector_type(2)));
__device__ __forceinline__ void st8(bf16_t* p, f32x4 v0, f32x4 v1) {
    u32x4 w; w.x = cvt_pk_bf16(v0[0], v0[1]); w.y = cvt_pk_bf16(v0[2], v0[3]); w.z = cvt_pk_bf16(v1[0], v1[1]); w.w = cvt_pk_bf16(v1[2], v1[3]); *(u32x4*)p = w;
}
template <int ACT  > struct EpiPlain {
    static constexpr bool PERM = true, AFTER_DRAIN = false;
    bf16_t* O; int ldc; const float* bias; const float* rs;
    __device__ __forceinline__ void operator()(const f32x4 (&acc)[2][2][4][2], const Unit& u, int wr, int wc, int fr, int fq) const {
        const int row0 = u.pm * BM + wr * 64 + fr, col0 = u.pn * BM + wc * 32 + 8 * fq;
        f32x4 bv[2][2];
#pragma unroll
        for (int bj = 0; bj < 2; ++bj)
#pragma unroll
            for (int n = 0; n < 2; ++n) bv[bj][n] = bias ? *(const f32x4*)(bias + col0 + bj * HALF + 4 * n) : (f32x4){0.f, 0.f, 0.f, 0.f};
#pragma unroll
        for (int ai = 0; ai < 2; ++ai)
#pragma unroll
            for (int m = 0; m < 4; ++m) { bf16_t* rowp = O + (size_t)(row0 + ai * HALF + m * 16) * ldc + col0; const float r = rs ? rs[row0 + ai * HALF + m * 16] : 1.f;
#pragma unroll
                for (int bj = 0; bj < 2; ++bj) { f32x4 v0 = acc[ai][bj][m][0] * r + bv[bj][0], v1 = acc[ai][bj][m][1] * r + bv[bj][1];
                    if (ACT == 1) {
#pragma unroll
                        for (int j = 0; j < 4; ++j) { const float a = fmaxf(v0[j], 0.f), b = fmaxf(v1[j], 0.f); v0[j] = a * a; v1[j] = b * b; } }
                    st8(rowp + bj * HALF, v0, v1); } }
    }
};
struct EpiInProj {
    static constexpr bool PERM = true, AFTER_DRAIN = false;
    bf16_t* O; int ldc; float* SS; const float* rs;
    __device__ __forceinline__ void operator()(const f32x4 (&acc)[2][2][4][2], const Unit& u, int wr, int wc, int fr, int fq) const {
        const int row0 = u.pm * BM + wr * 64 + fr, col0 = u.pn * BM + wc * 32 + 8 * fq;
#pragma unroll
        for (int ai = 0; ai < 2; ++ai)
#pragma unroll
            for (int m = 0; m < 4; ++m) { const int row = row0 + ai * HALF + m * 16; bf16_t* rowp = O + (size_t)row * ldc + col0; const float r = rs[row];
#pragma unroll
                for (int bj = 0; bj < 2; ++bj) { const f32x4 a = acc[ai][bj][m][0] * r, b = acc[ai][bj][m][1] * r; st8(rowp + bj * HALF, a, b);
                    const int grp = 8 * u.pn + 4 * bj + wc - 48;
                    if (grp >= 0 && grp < 20) {
                        float s = (a[0] * a[0] + a[1] * a[1]) + (a[2] * a[2] + a[3] * a[3]) + (b[0] * b[0] + b[1] * b[1]) + (b[2] * b[2] + b[3] * b[3]);
                        s += __shfl_xor(s, 16); s += __shfl_xor(s, 32);
                        if (fq == 0) SS[(size_t)row * 32 + grp] = s; } } }
    }
};
struct EpiRowScale {
    static constexpr bool PERM = true, AFTER_DRAIN = false;
    bf16_t* O; int ldc; const float* SS; int g0, ng4; float invk, eps;
    unsigned* km;
    __device__ __forceinline__ void operator()(const f32x4 (&acc)[2][2][4][2], const Unit& u, int wr, int wc, int fr, int fq) const {
        const int row0 = u.pm * BM + wr * 64 + fr, col0 = u.pn * BM + wc * 32 + 8 * fq;
        float mx[2] = {0.f, 0.f};
#pragma unroll
        for (int ai = 0; ai < 2; ++ai)
#pragma unroll
            for (int m = 0; m < 4; ++m) { const int row = row0 + ai * HALF + m * 16; const f32x4* sp = (const f32x4*)(SS + (size_t)row * 32) + g0;
                float s = 0.f; for (int t = 0; t < ng4; ++t) { const f32x4 v = sp[t]; s += (v[0] + v[1]) + (v[2] + v[3]); }
                const float r = rsqrtf(s * invk + eps);
                bf16_t* rowp = O + (size_t)row * ldc + col0;
#pragma unroll
                for (int bj = 0; bj < 2; ++bj) { const f32x4 a = acc[ai][bj][m][0] * r, b = acc[ai][bj][m][1] * r; st8(rowp + bj * HALF, a, b);
                    if (km && wc < 2) { float q = (a[0] * a[0] + a[1] * a[1]) + (a[2] * a[2] + a[3] * a[3]) + (b[0] * b[0] + b[1] * b[1]) + (b[2] * b[2] + b[3] * b[3]);
                        q += __shfl_xor(q, 16); q += __shfl_xor(q, 32); mx[bj] = fmaxf(mx[bj], q); } } }
        if (km && wc < 2) {
#pragma unroll
            for (int bj = 0; bj < 2; ++bj) { float v = mx[bj];
#pragma unroll
                for (int o = 1; o < 16; o <<= 1) v = fmaxf(v, __shfl_xor(v, o));
                if (fr == 0 && fq == 0) __hip_atomic_fetch_max(km + ((u.pm >> 5) * 8 + 2 * u.pn + bj) * 4 + wc, __float_as_uint(v), __ATOMIC_RELAXED, __HIP_MEMORY_SCOPE_AGENT); }
        }
    }
};
struct EpiGLU {
    static constexpr bool PERM = true, AFTER_DRAIN = false;
    bf16_t* O; int ldc; const float* bias; const float* rs;
    __device__ __forceinline__ void operator()(const f32x4 (&acc)[2][2][4][2], const Unit& u, int wr, int wc, int fr, int fq) const {
        const int row0 = u.pm * BM + wr * 64 + fr, ch0 = u.pn * HALF + wc * 32 + 8 * fq;
        f32x4 ba[2], bg[2];
#pragma unroll
        for (int n = 0; n < 2; ++n) { ba[n] = *(const f32x4*)(bias + ch0 + 4 * n); bg[n] = *(const f32x4*)(bias + 1024 + ch0 + 4 * n); }
#pragma unroll
        for (int ai = 0; ai < 2; ++ai)
#pragma unroll
            for (int m = 0; m < 4; ++m) { f32x4 o[2]; const float r = rs[row0 + ai * HALF + m * 16];
#pragma unroll
                for (int n = 0; n < 2; ++n) { const f32x4 a = acc[ai][0][m][n] * r + ba[n], g = acc[ai][1][m][n] * r + bg[n];
#pragma unroll
                    for (int j = 0; j < 4; ++j) o[n][j] = a[j] * __builtin_amdgcn_rcpf(1.f + __builtin_amdgcn_exp2f(-1.4426950408889634f * g[j])); }
                st8(O + (size_t)(row0 + ai * HALF + m * 16) * ldc + ch0, o[0], o[1]); }
    }
};

template <class Epi, class Sched, bool ALIGN_EPI = false, bool SP2 = false>
__device__ __forceinline__ void gemm_phase(PG8_LAS unsigned char* lds, const Gemm g, const Sched& S, const Epi& E) {
    const int tid = threadIdx.x, wid = __builtin_amdgcn_readfirstlane(tid >> 6), lane = tid & 63, wr = wid >> 2, wc = wid & 3, fr = lane & 15, fq = lane >> 4;
    const int K = g.K, nt = K / BK;
    unsigned voffA[2], voffB[2];
#pragma unroll
    for (int i = 0; i < 2; ++i) { int R, C; stage_rc(tid * 16 + i * 8192, R, C); const int Rb = Epi::PERM ? ((R & ~31) + perm32(R & 31)) : R;
        voffA[i] = (unsigned)(R * g.lda + C) * 2u; voffB[i] = (unsigned)(Rb * K + C) * 2u; }
    const size_t kstep = (size_t)(BK * 2);
    const size_t hstepA = (size_t)HALF * g.lda * 2, hstepB = (size_t)HALF * K * 2;
    const size_t tstepA = 2 * hstepA, tstepB = 2 * hstepB;
    const unsigned ldsw = (unsigned)wid * 1024u;
    const int aoff = lds_byte(wr * 64 + fr, fq * 8), boff = lds_byte(wc * 32 + fr, fq * 8);
#define PG8_SA(b, h) (((b) * 2 + (h)) * HTB)
#define PG8_SB(b, h) ((4 + (b) * 2 + (h)) * HTB)
#define PG8_STAGE(bufoff, gbase, voff) do { _Pragma("unroll") for (int _i = 0; _i < 2; ++_i) \
        __builtin_amdgcn_global_load_lds((const unsigned*)((const char*)(gbase) + (voff)[_i]), (PG8_LAS unsigned*)(lds + (bufoff) + ldsw + _i * 8192), 16, 0, 0); } while (0)
#define PG8_LDA(dst, b, h) do { _Pragma("unroll") for (int m = 0; m < 4; ++m) _Pragma("unroll") for (int k = 0; k < 2; ++k) dst[m][k] = *(const PG8_LAS bf16x8*)(lds + PG8_SA(b, h) + aoff + m * 2048 + k * 1024); } while (0)
#define PG8_LDB(dst, b, h) do { _Pragma("unroll") for (int n = 0; n < 2; ++n) _Pragma("unroll") for (int k = 0; k < 2; ++k) dst[n][k] = *(const PG8_LAS bf16x8*)(lds + PG8_SB(b, h) + boff + n * 2048 + k * 1024); } while (0)
#define PG8_MMA(ai, bj, At, Bt) do { __builtin_amdgcn_s_setprio(1); _Pragma("unroll") for (int m = 0; m < 4; ++m) _Pragma("unroll") for (int n = 0; n < 2; ++n) _Pragma("unroll") for (int k = 0; k < 2; ++k) \
        acc[ai][bj][m][n] = __builtin_amdgcn_mfma_f32_16x16x32_bf16(Bt[n][k], At[m][k], acc[ai][bj][m][n], 0, 0, 0); __builtin_amdgcn_s_setprio(0); } while (0)
#define PG8_WAIT_V(n) asm volatile("s_waitcnt vmcnt(" #n ")" ::: "memory")
#define PG8_WAIT_L(n) asm volatile("s_waitcnt lgkmcnt(" #n ")" ::: "memory")
#define PG8_BAR __builtin_amdgcn_s_barrier()
#define PG8_SCHED __builtin_amdgcn_sched_barrier(0)
    Unit cur, nxt; int ui = 0;
    if (!S.next(0, cur)) return;
    f32x4 acc[2][2][4][2];
#pragma unroll
    for (int a = 0; a < 2; ++a)
#pragma unroll
        for (int b = 0; b < 2; ++b)
#pragma unroll
            for (int m = 0; m < 4; ++m)
#pragma unroll
                for (int n = 0; n < 2; ++n) acc[a][b][m][n] = (f32x4){0.f, 0.f, 0.f, 0.f};
    bf16x8 At[4][2], B0[2][2], B1[2][2];
    const char* cA = (const char*)g.A + (size_t)cur.pm * tstepA; const char* cB = (const char*)g.Bt + (size_t)cur.pn * tstepB;
    S.a_ready(cur);
    if constexpr (SP2) {
        PG8_STAGE(PG8_SB(0, 0), cB, voffB); PG8_STAGE(PG8_SB(0, 1), cB + hstepB, voffB); PG8_STAGE(PG8_SA(0, 0), cA, voffA); PG8_STAGE(PG8_SA(0, 1), cA + hstepA, voffA);
        if (wr == 1) PG8_BAR;
        PG8_WAIT_V(2); PG8_BAR;
        PG8_STAGE(PG8_SB(1, 0), cB + kstep, voffB); PG8_STAGE(PG8_SA(1, 0), cA + kstep, voffA); PG8_STAGE(PG8_SB(1, 1), cB + hstepB + kstep, voffB);
        PG8_WAIT_V(6); PG8_BAR;
    } else {
        PG8_STAGE(PG8_SB(0, 0), cB, voffB); PG8_STAGE(PG8_SA(0, 0), cA, voffA); PG8_STAGE(PG8_SB(0, 1), cB + hstepB, voffB); PG8_STAGE(PG8_SA(0, 1), cA + hstepA, voffA);
        if (wr == 1) PG8_BAR;
        PG8_WAIT_V(4); PG8_BAR;
        PG8_STAGE(PG8_SB(1, 0), cB + kstep, voffB); PG8_STAGE(PG8_SA(1, 0), cA + kstep, voffA); PG8_STAGE(PG8_SB(1, 1), cB + hstepB + kstep, voffB);
        PG8_WAIT_V(6); PG8_BAR;
    }
    for (;;) {
        const bool has_next = S.next(ui + 1, nxt);
        const char* nA = has_next ? (const char*)g.A + (size_t)nxt.pm * tstepA : cA; const char* nB = has_next ? (const char*)g.Bt + (size_t)nxt.pn * tstepB : cB;
        for (int t = 0; t < nt; t += 2) {
            const bool last = (t == nt - 2);
            const char* a1 = cA + (size_t)(t + 1) * kstep;
            const char* a2 = last ? nA : cA + (size_t)(t + 2) * kstep; const char* b2 = last ? nB : cB + (size_t)(t + 2) * kstep;
            const char* a3 = a2 + kstep; const char* b3 = b2 + kstep;
            if (last && has_next) S.a_ready(nxt);
            if constexpr (SP2) {
            PG8_LDB(B0, 0, 0); PG8_LDB(B1, 0, 1); PG8_SCHED; PG8_LDA(At, 0, 0); PG8_STAGE(PG8_SA(1, 1), a1 + hstepA, voffA);
            PG8_WAIT_V(8); PG8_WAIT_L(0); PG8_BAR; PG8_MMA(0, 0, At, B0); PG8_MMA(0, 1, At, B1); PG8_BAR; PG8_SCHED;
            PG8_LDA(At, 0, 1); PG8_STAGE(PG8_SB(0, 0), b2, voffB); PG8_STAGE(PG8_SB(0, 1), b2 + hstepB, voffB); PG8_STAGE(PG8_SA(0, 0), a2, voffA);
            PG8_WAIT_V(8); PG8_WAIT_L(0); PG8_BAR; PG8_MMA(1, 0, At, B0); PG8_MMA(1, 1, At, B1); PG8_BAR; PG8_SCHED;
            PG8_LDB(B0, 1, 0); PG8_LDB(B1, 1, 1); PG8_SCHED; PG8_LDA(At, 1, 0); PG8_STAGE(PG8_SA(0, 1), a2 + hstepA, voffA);
            PG8_WAIT_V(8); PG8_WAIT_L(0); PG8_BAR; PG8_MMA(0, 0, At, B0); PG8_MMA(0, 1, At, B1); PG8_BAR; PG8_SCHED;
            PG8_LDA(At, 1, 1); PG8_STAGE(PG8_SB(1, 0), b3, voffB); PG8_STAGE(PG8_SB(1, 1), b3 + hstepB, voffB); PG8_STAGE(PG8_SA(1, 0), a3, voffA);
            PG8_WAIT_V(8); PG8_WAIT_L(0); PG8_BAR; PG8_MMA(1, 0, At, B0); PG8_MMA(1, 1, At, B1); PG8_BAR; PG8_SCHED;
            } else {
            PG8_LDB(B0, 0, 0); PG8_SCHED; PG8_LDA(At, 0, 0); PG8_STAGE(PG8_SA(1, 1), a1 + hstepA, voffA);
            PG8_WAIT_L(8); PG8_BAR; PG8_WAIT_L(0); PG8_MMA(0, 0, At, B0); PG8_BAR; PG8_SCHED;
            PG8_LDB(B1, 0, 1); PG8_STAGE(PG8_SB(0, 0), b2, voffB);
            PG8_BAR; PG8_WAIT_L(0); PG8_MMA(0, 1, At, B1); PG8_BAR;
            PG8_LDA(At, 0, 1); PG8_STAGE(PG8_SA(0, 0), a2, voffA);
            PG8_BAR; PG8_WAIT_L(0); PG8_MMA(1, 0, At, B0); PG8_BAR; PG8_SCHED;
            PG8_STAGE(PG8_SB(0, 1), b2 + hstepB, voffB);
            PG8_WAIT_V(6); PG8_BAR; PG8_MMA(1, 1, At, B1); PG8_BAR;
            PG8_LDB(B0, 1, 0); PG8_SCHED; PG8_LDA(At, 1, 0); PG8_STAGE(PG8_SA(0, 1), a2 + hstepA, voffA);
            PG8_WAIT_L(8); PG8_BAR; PG8_WAIT_L(0); PG8_MMA(0, 0, At, B0); PG8_BAR; PG8_SCHED;
            PG8_LDB(B1, 1, 1); PG8_STAGE(PG8_SB(1, 0), b3, voffB);
            PG8_BAR; PG8_WAIT_L(0); PG8_MMA(0, 1, At, B1); PG8_BAR;
            PG8_LDA(At, 1, 1); PG8_STAGE(PG8_SA(1, 0), a3, voffA);
            PG8_BAR; PG8_WAIT_L(0); PG8_MMA(1, 0, At, B0); PG8_BAR; PG8_SCHED;
            PG8_STAGE(PG8_SB(1, 1), b3 + hstepB, voffB);
            PG8_WAIT_V(6); PG8_BAR; PG8_MMA(1, 1, At, B1); PG8_BAR;
            }
        }
        if constexpr (ALIGN_EPI) { if (wr == 0) PG8_BAR; }
        if constexpr (!Epi::AFTER_DRAIN) { E(acc, cur, wr, wc, fr, fq); S.done(cur); }
        if (!has_next) break;
#pragma unroll
        for (int a = 0; a < 2; ++a)
#pragma unroll
            for (int b = 0; b < 2; ++b)
#pragma unroll
                for (int m = 0; m < 4; ++m)
#pragma unroll
                    for (int n = 0; n < 2; ++n) acc[a][b][m][n] = (f32x4){0.f, 0.f, 0.f, 0.f};
        cur = nxt; cA = nA; cB = nB; ++ui;
        if constexpr (ALIGN_EPI) { if (wr == 1) PG8_BAR; }
    }
    PG8_WAIT_V(0);
    if constexpr (!ALIGN_EPI) { if (wr == 0) PG8_BAR; }
    PG8_BAR;
    if constexpr (Epi::AFTER_DRAIN) { E.fused(acc, cur, wr, wc, fr, fq, lds, wid, lane); S.done(cur); }
#undef PG8_SA
#undef PG8_SB
#undef PG8_STAGE
#undef PG8_LDA
#undef PG8_LDB
#undef PG8_MMA
#undef PG8_WAIT_V
#undef PG8_WAIT_L
#undef PG8_BAR
#undef PG8_SCHED
}
}
namespace att {
using bf16x8 = __attribute__((ext_vector_type(8))) short;
using s16x4  = __attribute__((ext_vector_type(4))) short;
using f32x16 = __attribute__((ext_vector_type(16))) float;
using f32x8  = __attribute__((ext_vector_type(8))) float;
using u32x4  = __attribute__((ext_vector_type(4))) unsigned;
typedef unsigned short bf16_t;
constexpr int NW = 8, QBLK = 32, KVBLK = 64, SEQ = 8192, NHEAD = 8;
constexpr int LDQ = 768, LDKV = 1024, LDPE = 32, LDO = 1024;
constexpr float SCALE = 0.10206207261596575f;
constexpr int SHM_K = KVBLK * 256, SHM_V = KVBLK * 64 * 2;
#define KSWZ(row, colB) ((row) * 256 + ((colB) ^ (((row) & 15) << 4)))
#define SBAR() __builtin_amdgcn_sched_barrier(0)
__device__ __forceinline__ int crow(int r, int hi) { return (r & 3) + 8 * (r >> 2) + 4 * hi; }
__device__ __forceinline__ unsigned cvtpk(float lo, float hi) { unsigned r; asm volatile("v_cvt_pk_bf16_f32 %0, %1, %2" : "=v"(r) : "v"(lo), "v"(hi)); return r; }
__device__ __forceinline__ float bf2f(short v) { return __uint_as_float(((unsigned)(unsigned short)v) << 16); }
__device__ __forceinline__ bf16x8 ld8(const bf16_t* p) { return *reinterpret_cast<const bf16x8*>(p); }

__device__ __forceinline__ void partialSM(f32x16& p0) {
#pragma unroll
  for (int r = 0; r < 16; ++r) p0[r] = __builtin_amdgcn_exp2f(p0[r]);
}
__device__ __forceinline__ void finishSM(f32x16& p0, f32x16& p1, float& l_reg, bf16x8& pa0, bf16x8& pa1, bf16x8& pa2, bf16x8& pa3) {
#pragma unroll
  for (int r = 0; r < 16; ++r) p1[r] = __builtin_amdgcn_exp2f(p1[r]);
  float ps = 0;
#pragma unroll
  for (int r = 0; r < 16; ++r) ps += p0[r];
#pragma unroll
  for (int r = 0; r < 16; ++r) ps += p1[r];
  { auto rr = __builtin_amdgcn_permlane32_swap(__float_as_uint(ps), __float_as_uint(ps), false, false);
    ps = __uint_as_float(rr[0]) + __uint_as_float(rr[1]); }
  l_reg += ps;
#define PK4(P, BASE, OUT) do { u32x4 w = {cvtpk(P[BASE + 0], P[BASE + 1]), cvtpk(P[BASE + 2], P[BASE + 3]), cvtpk(P[BASE + 4], P[BASE + 5]), cvtpk(P[BASE + 6], P[BASE + 7])}; \
    OUT = *reinterpret_cast<bf16x8*>(&w); } while (0)
  PK4(p0, 0, pa0); PK4(p0, 8, pa1); PK4(p1, 0, pa2); PK4(p1, 8, pa3);
#undef PK4
}
__device__ __forceinline__ void qkt(f32x16& p0, f32x16& p1, const char* Ks, const bf16x8* qr, const f32x16& negm, int r32, int hi) {
#pragma unroll
  for (int d0 = 0; d0 < 6; ++d0) { int cb = (d0 * 16 + hi * 8) * 2;
    bf16x8 b0 = *reinterpret_cast<const bf16x8*>(Ks + KSWZ(r32, cb));
    bf16x8 b1 = *reinterpret_cast<const bf16x8*>(Ks + KSWZ(32 + r32, cb));
    if (d0 == 0) { p0 = __builtin_amdgcn_mfma_f32_32x32x16_bf16(b0, qr[0], negm, 0, 0, 0); p1 = __builtin_amdgcn_mfma_f32_32x32x16_bf16(b1, qr[0], negm, 0, 0, 0); }
    else { p0 = __builtin_amdgcn_mfma_f32_32x32x16_bf16(b0, qr[d0], p0, 0, 0, 0); p1 = __builtin_amdgcn_mfma_f32_32x32x16_bf16(b1, qr[d0], p1, 0, 0, 0); } }
}
__device__ __forceinline__ int v_st(int k, int c) { const int kk = (k & ~0xC) | ((k & 4) << 1) | ((k & 8) >> 1); return ((kk >> 3) * 2 + (c >> 5)) * 512 + ((kk & 7) * 32 + (c & 31)) * 2; }
__device__ __forceinline__ int v_rd_base(int lane) { return ((lane & 3) << 3) | (((lane >> 2) & 3) << 6) | (((lane >> 4) & 1) << 5) | (((lane >> 5) & 1) << 8); }
constexpr int v_rd_off(int d0, int ks, int half) { return d0 * 512 + ks * 2048 + half * 1024; }
template <int OFF> __device__ __forceinline__ s16x4 tr_read(int vb) {
  s16x4 r; asm volatile("ds_read_b64_tr_b16 %0, %1 offset:%2" : "=&v"(r) : "v"(vb), "i"(OFF) : "memory"); return r;
}
template <int D0> __device__ __forceinline__ void pv_one(f32x16& od, int vb, bf16x8 pa0, bf16x8 pa1, bf16x8 pa2, bf16x8 pa3) {
  const s16x4 l0 = tr_read<v_rd_off(D0, 0, 0)>(vb), h0 = tr_read<v_rd_off(D0, 0, 1)>(vb), l1 = tr_read<v_rd_off(D0, 1, 0)>(vb), h1 = tr_read<v_rd_off(D0, 1, 1)>(vb);
  const s16x4 l2 = tr_read<v_rd_off(D0, 2, 0)>(vb), h2 = tr_read<v_rd_off(D0, 2, 1)>(vb), l3 = tr_read<v_rd_off(D0, 3, 0)>(vb), h3 = tr_read<v_rd_off(D0, 3, 1)>(vb);
  asm volatile("s_waitcnt lgkmcnt(0)" ::: "memory"); SBAR();
#define PK(L, H) (bf16x8){L[0], L[1], L[2], L[3], H[0], H[1], H[2], H[3]}
  od = __builtin_amdgcn_mfma_f32_32x32x16_bf16(pa0, PK(l0, h0), od, 0, 0, 0);
  od = __builtin_amdgcn_mfma_f32_32x32x16_bf16(pa1, PK(l1, h1), od, 0, 0, 0);
  od = __builtin_amdgcn_mfma_f32_32x32x16_bf16(pa2, PK(l2, h2), od, 0, 0, 0);
  od = __builtin_amdgcn_mfma_f32_32x32x16_bf16(pa3, PK(l3, h3), od, 0, 0, 0);
#undef PK
}
__device__ __forceinline__ void pv_d0(f32x16* o, int vb, bf16x8 pa0, bf16x8 pa1, bf16x8 pa2, bf16x8 pa3) {
  pv_one<0>(o[0], vb, pa0, pa1, pa2, pa3); pv_one<1>(o[1], vb, pa0, pa1, pa2, pa3);
}
struct VF4 { s16x4 l0, h0, l1, h1; };
__device__ __forceinline__ void pv_load_a(VF4& f, int vb) {
  f.l0 = tr_read<v_rd_off(0, 0, 0)>(vb); f.h0 = tr_read<v_rd_off(0, 0, 1)>(vb); f.l1 = tr_read<v_rd_off(1, 0, 0)>(vb); f.h1 = tr_read<v_rd_off(1, 0, 1)>(vb);
}
__device__ __forceinline__ void pv_all(f32x16* o, const VF4& f, int vb, bf16x8 pa0, bf16x8 pa1, bf16x8 pa2, bf16x8 pa3, f32x16& pn) {
#define EX4(B) do { pn[B] = __builtin_amdgcn_exp2f(pn[B]); pn[B + 1] = __builtin_amdgcn_exp2f(pn[B + 1]); pn[B + 2] = __builtin_amdgcn_exp2f(pn[B + 2]); pn[B + 3] = __builtin_amdgcn_exp2f(pn[B + 3]); } while (0)
#define PK(L, H) (bf16x8){L[0], L[1], L[2], L[3], H[0], H[1], H[2], H[3]}
  const s16x4 b0l = tr_read<v_rd_off(0, 1, 0)>(vb), b0h = tr_read<v_rd_off(0, 1, 1)>(vb), b1l = tr_read<v_rd_off(1, 1, 0)>(vb), b1h = tr_read<v_rd_off(1, 1, 1)>(vb);
  const s16x4 c0l = tr_read<v_rd_off(0, 2, 0)>(vb), c0h = tr_read<v_rd_off(0, 2, 1)>(vb), c1l = tr_read<v_rd_off(1, 2, 0)>(vb), c1h = tr_read<v_rd_off(1, 2, 1)>(vb);
  asm volatile("s_waitcnt lgkmcnt(8)" ::: "memory"); SBAR();
  o[0] = __builtin_amdgcn_mfma_f32_32x32x16_bf16(pa0, PK(f.l0, f.h0), o[0], 0, 0, 0);
  o[1] = __builtin_amdgcn_mfma_f32_32x32x16_bf16(pa0, PK(f.l1, f.h1), o[1], 0, 0, 0);
  EX4(0); SBAR();
  const s16x4 d0l = tr_read<v_rd_off(0, 3, 0)>(vb), d0h = tr_read<v_rd_off(0, 3, 1)>(vb), d1l = tr_read<v_rd_off(1, 3, 0)>(vb), d1h = tr_read<v_rd_off(1, 3, 1)>(vb);
  asm volatile("s_waitcnt lgkmcnt(8)" ::: "memory"); SBAR();
  o[0] = __builtin_amdgcn_mfma_f32_32x32x16_bf16(pa1, PK(b0l, b0h), o[0], 0, 0, 0);
  o[1] = __builtin_amdgcn_mfma_f32_32x32x16_bf16(pa1, PK(b1l, b1h), o[1], 0, 0, 0);
  EX4(4); SBAR(); asm volatile("s_waitcnt lgkmcnt(4)" ::: "memory"); SBAR();
  o[0] = __builtin_amdgcn_mfma_f32_32x32x16_bf16(pa2, PK(c0l, c0h), o[0], 0, 0, 0);
  o[1] = __builtin_amdgcn_mfma_f32_32x32x16_bf16(pa2, PK(c1l, c1h), o[1], 0, 0, 0);
  EX4(8); SBAR(); asm volatile("s_waitcnt lgkmcnt(0)" ::: "memory"); SBAR();
  o[0] = __builtin_amdgcn_mfma_f32_32x32x16_bf16(pa3, PK(d0l, d0h), o[0], 0, 0, 0);
  o[1] = __builtin_amdgcn_mfma_f32_32x32x16_bf16(pa3, PK(d1l, d1h), o[1], 0, 0, 0);
  EX4(12);
#undef PK
#undef EX4
}
__device__ __forceinline__ void glds16(const void* gsrc, unsigned lds_dst) { unsigned keep;
  asm volatile("s_mov_b32 %0, m0\n\ts_mov_b32 m0, %2\n\ts_nop 0\n\tglobal_load_lds_dwordx4 %1, off\n\ts_mov_b32 m0, %0" : "=&s"(keep) : "v"(gsrc), "s"(lds_dst) : "memory"); }
#define WAIT_BAR(N) asm volatile("s_waitcnt vmcnt(" #N ") lgkmcnt(0)\n\ts_barrier" ::: "memory")
constexpr int RING_K = 0, RING_V = 3 * SHM_K, RING_WS = RING_V + 3 * SHM_V, ATT_LDS = RING_WS + NW * 64 * 4;

__device__ __forceinline__ void attn_unit(const bf16_t* __restrict__ Qb, const bf16_t* __restrict__ KVh, const bf16_t* __restrict__ PEb, const float* __restrict__ CSq,
                                          bf16_t* __restrict__ Ob, char* lds, float kmax) {
  const int tid = threadIdx.x, lane = tid & 63, r32 = lane & 31, hi = lane >> 5; const int wid = __builtin_amdgcn_readfirstlane(tid >> 6);
  char* V_lds = lds + RING_V; char* K_lds = lds + RING_K;
  float* ws = (float*)(lds + RING_WS) + wid * 64; float* li_l = ws; float* al_l = ws + 32;
  const unsigned lds0 = (unsigned)(uintptr_t)lds;
  const char* ksrc0; const char* ksrc1; unsigned kstride;
  { const int rr = lane >> 4, cp = lane & 15;
    const int r0 = 8 * wid + rr, c0 = cp ^ (r0 & 15), r1 = r0 + 4, c1 = cp ^ (r1 & 15);
    ksrc0 = (c0 < 8) ? (const char*)(KVh + (long)r0 * LDKV + c0 * 8) : (const char*)(PEb + (long)r0 * LDPE + (c0 & 3) * 8);
    ksrc1 = (c1 < 8) ? (const char*)(KVh + (long)r1 * LDKV + c1 * 8) : (const char*)(PEb + (long)r1 * LDPE + (c1 & 3) * 8);
    kstride = 0; }
  unsigned kst0, kst1;
  { const int cp = lane & 15, rr = lane >> 4; const int c0 = cp ^ ((8 * wid + rr) & 15), c1 = cp ^ ((8 * wid + rr + 4) & 15);
    kst0 = (c0 < 8) ? KVBLK * LDKV * 2 : KVBLK * LDPE * 2; kst1 = (c1 < 8) ? KVBLK * LDKV * 2 : KVBLK * LDPE * 2; }
  (void)kstride;
  const char* vsrc;
  { const int kk = 8 * wid + ((lane & 31) >> 2), k = kk, col = (lane >> 5) * 32 + (lane & 3) * 8;
    vsrc = (const char*)(KVh + (long)k * LDKV + 64 + col); }
  const unsigned kdst = lds0 + RING_K + wid * 2048, vdst = lds0 + RING_V + wid * 1024;
#define DMA_K(slot) do { glds16(ksrc0, (unsigned)__builtin_amdgcn_readfirstlane(kdst + (slot) * SHM_K)); glds16(ksrc1, (unsigned)__builtin_amdgcn_readfirstlane(kdst + (slot) * SHM_K + 1024)); \
    ksrc0 += kst0; ksrc1 += kst1; } while (0)
#define DMA_V(slot) do { glds16(vsrc, (unsigned)__builtin_amdgcn_readfirstlane(vdst + (slot) * SHM_V)); vsrc += KVBLK * LDKV * 2; } while (0)
  DMA_K(0); DMA_V(0); DMA_K(1);
  float l_reg = 0; f32x16 o[2] = {}; bf16x8 qr[6]; f32x16 negm;
  const bf16_t* Qw = Qb + (long)(wid * QBLK + r32) * LDQ + hi * 8;
#pragma unroll
  for (int d0 = 0; d0 < 6; ++d0) qr[d0] = ld8(Qw + d0 * 16);
  {
    const float* cs = CSq + (long)(wid * QBLK + r32) * 32 + hi * 8;
    const f32x8 c = *reinterpret_cast<const f32x8*>(cs), s = *reinterpret_cast<const f32x8*>(cs + 16);
    constexpr float QC = SCALE * 1.4426950408889634f;
    float y1[8], y2[8];
#pragma unroll
    for (int j = 0; j < 8; ++j) { const float x1 = bf2f(qr[4][j]) * QC, x2 = bf2f(qr[5][j]) * QC; y1[j] = x1 * c[j] - x2 * s[j]; y2[j] = x2 * c[j] + x1 * s[j]; }
#pragma unroll
    for (int d0 = 0; d0 < 4; ++d0) { float z[8];
#pragma unroll
      for (int j = 0; j < 8; ++j) z[j] = bf2f(qr[d0][j]) * QC;
      u32x4 wz = {cvtpk(z[0], z[1]), cvtpk(z[2], z[3]), cvtpk(z[4], z[5]), cvtpk(z[6], z[7])}; qr[d0] = *reinterpret_cast<bf16x8*>(&wz); }
    u32x4 w1 = {cvtpk(y1[0], y1[1]), cvtpk(y1[2], y1[3]), cvtpk(y1[4], y1[5]), cvtpk(y1[6], y1[7])};
    u32x4 w2 = {cvtpk(y2[0], y2[1]), cvtpk(y2[2], y2[3]), cvtpk(y2[4], y2[5]), cvtpk(y2[6], y2[7])};
    qr[4] = *reinterpret_cast<bf16x8*>(&w1); qr[5] = *reinterpret_cast<bf16x8*>(&w2);
  }
  { float q2 = 0.f;
#pragma unroll
    for (int d0 = 0; d0 < 6; ++d0)
#pragma unroll
      for (int j = 0; j < 8; ++j) { const float t = bf2f(qr[d0][j]); q2 = fmaf(t, t, q2); }
    auto rr = __builtin_amdgcn_permlane32_swap(__float_as_uint(q2), __float_as_uint(q2), false, false);
    const float bref = sqrtf(__uint_as_float(rr[0]) + __uint_as_float(rr[1])) * kmax;
#pragma unroll
    for (int r = 0; r < 16; ++r) negm[r] = -bref; }
  const int vb0 = (int)(uintptr_t)V_lds + v_rd_base(lane);
  f32x16 pA0, pA1, pB0, pB1; bf16x8 pa0, pa1, pa2, pa3; constexpr int NT = SEQ / KVBLK;
  int s_prev = 2, s_cur = 0, s_next = 1;
#define ROT() do { const int t_ = s_prev; s_prev = s_cur; s_cur = s_next; s_next = t_; } while (0)
  WAIT_BAR(0);
  DMA_K(2); DMA_V(1);
  qkt(pA0, pA1, K_lds, qr, negm, r32, hi); partialSM(pA0);
  ROT();
#define ITER(PN0, PN1, PP0, PP1, GK, GV) do { \
    if (GK) DMA_K(s_prev); if (GV) DMA_V(s_next); \
    VF4 vf_; pv_load_a(vf_, vb0 + s_prev * SHM_V);         \
    SBAR(); qkt(PN0, PN1, K_lds + s_cur * SHM_K, qr, negm, r32, hi); \
    finishSM(PP0, PP1, l_reg, pa0, pa1, pa2, pa3); SBAR(); \
    pv_all(o, vf_, vb0 + s_prev * SHM_V, pa0, pa1, pa2, pa3, PN0); asm volatile("" : "+v"(PN0)); SBAR(); \
    ROT(); } while (0)
  for (int j = 1; j + 2 < NT; j += 2) {
    WAIT_BAR(3); ITER(pB0, pB1, pA0, pA1, true, true);
    WAIT_BAR(3); ITER(pA0, pA1, pB0, pB1, (j + 3 < NT), true);
  }
  WAIT_BAR(0); ITER(pB0, pB1, pA0, pA1, false, false);
  finishSM(pB0, pB1, l_reg, pa0, pa1, pa2, pa3); SBAR();
  pv_d0(o, vb0 + s_prev * SHM_V, pa0, pa1, pa2, pa3);
  if (hi == 0) li_l[r32] = l_reg; asm volatile("s_waitcnt lgkmcnt(0)" ::: "memory");
  float rli[16];
#pragma unroll
  for (int r = 0; r < 16; ++r) rli[r] = __builtin_amdgcn_rcpf(li_l[crow(r, hi)]);
  bf16_t* Ow = Ob + (long)(wid * QBLK) * LDO;
#pragma unroll
  for (int r = 0; r < 16; ++r) { const int orow = crow(r, hi);
#pragma unroll
    for (int d0 = 0; d0 < 2; ++d0) { const unsigned w = cvtpk(o[d0][r] * rli[r], 0.f); Ow[(long)orow * LDO + d0 * 32 + r32] = (bf16_t)(w & 0xffffu); } }
  asm volatile("s_waitcnt lgkmcnt(0)\n\ts_barrier" ::: "memory");
#undef DMA_K
#undef DMA_V
#undef ITER
#undef ROT
}
#undef WAIT_BAR
#undef KSWZ
#undef SBAR
}

constexpr int NWAVES = 8, NTHR = NWAVES * 64;
constexpr int BATCH = 4, SEQ = 8192, D = 1024, M = BATCH * SEQ, FF = 4096;
constexpr int INC = 2208, INP = 2304;
constexpr int QR = 384, KVR = 256, NQ = 768, NKV = 1024;
constexpr float EPS = 1e-6f;
#ifndef MK_PER_PHASE
#define MK_PER_PHASE 0
#endif
constexpr int N_PHASES = 16;
#ifndef PROBE_PHASE
#define PROBE_PHASE -1
#endif

constexpr size_t MiB = 1u << 20;
constexpr size_t WS_WIN = 1 * MiB;
constexpr size_t WS_WUQ = 6 * MiB;
constexpr size_t WS_WUKV = 7 * MiB;
constexpr size_t WS_WOUT = 8 * MiB;
constexpr size_t WS_WPW1 = 10 * MiB;
constexpr size_t WS_WPW2 = 14 * MiB;
constexpr size_t WS_W1 = 16 * MiB;
constexpr size_t WS_W2 = 32 * MiB;
constexpr size_t WS_CS = 48 * MiB;
constexpr size_t WS_KPE = 52 * MiB;
constexpr size_t WS_RS = 54 * MiB;
constexpr size_t WS_SS = 56 * MiB;
constexpr size_t WS_XN = 64 * MiB;
constexpr size_t WS_MO = 128 * MiB;
constexpr size_t WS_U = 192 * MiB;
constexpr size_t WS_PROJ = 192 * MiB;
constexpr size_t WS_Q = 336 * MiB;
constexpr size_t WS_KV = 384 * MiB;
constexpr size_t WS_G = 192 * MiB;
constexpr size_t WS_C = 256 * MiB;
constexpr size_t WS_MIX = 448 * MiB;
constexpr size_t WS_END = 512 * MiB;

constexpr int LDS_BYTES = 135168;

#define LAS __attribute__((address_space(3)))
typedef unsigned short bf16;
typedef unsigned v4u __attribute__((ext_vector_type(4)));
typedef unsigned v2u __attribute__((ext_vector_type(2)));
typedef float f32x4 __attribute__((ext_vector_type(4)));
typedef float f32x2 __attribute__((ext_vector_type(2)));
typedef short bf16x8 __attribute__((ext_vector_type(8)));
__device__ __forceinline__ unsigned pk2(float lo, float hi) { return pg8::cvt_pk_bf16(lo, hi); }
__device__ __forceinline__ float bflo(unsigned w) { return __uint_as_float(w << 16); }
__device__ __forceinline__ float bfhi(unsigned w) { return __uint_as_float(w & 0xffff0000u); }
__device__ __forceinline__ float wave_sum(float v) {
#pragma unroll
    for (int o = 1; o < 64; o <<= 1) v += __shfl_xor(v, o);
    return v;
}
template <int CTRL> __device__ __forceinline__ float dpp_get(float v) { return __int_as_float(__builtin_amdgcn_update_dpp(0, __float_as_int(v), CTRL, 0xf, 0xf, false)); }
__device__ __forceinline__ float wave_sum_dpp(float v) {
    v += dpp_get<0xB1>(v);
    v += dpp_get<0x4E>(v);
    v += dpp_get<0x141>(v);
    v += dpp_get<0x140>(v);
    { auto rr = __builtin_amdgcn_permlane16_swap(__float_as_uint(v), __float_as_uint(v), false, false); v = __uint_as_float(rr[0]) + __uint_as_float(rr[1]); }
    { auto rr = __builtin_amdgcn_permlane32_swap(__float_as_uint(v), __float_as_uint(v), false, false); v = __uint_as_float(rr[0]) + __uint_as_float(rr[1]); }
    return v;
}


#define XB_TMO      128
#define XB_XCNT(j)  (256  + 64 * (j))
#define XB_XSUB(j)  (1280 + 64 * (j))
#define XB_XGEN(j)  (2304 + 64 * (j))
#define XB_TOP      3328
#define XB_TOPGEN   3392
#define XCD_BAR_WORDS 3456
#define XB_SPIN_CAP (1u << 18)

__device__ __forceinline__ unsigned xb_ld(unsigned* p)              { return __hip_atomic_load(p, __ATOMIC_RELAXED, __HIP_MEMORY_SCOPE_AGENT); }
__device__ __forceinline__ unsigned xb_add(unsigned* p, unsigned v) { return __hip_atomic_fetch_add(p, v, __ATOMIC_RELAXED, __HIP_MEMORY_SCOPE_AGENT); }
__device__ __forceinline__ unsigned xb_xcc_id() { return (unsigned)__builtin_amdgcn_s_getreg((3 << 11) | 20) & 0xFu; }
#define XB_SPIN(cond, bar) do { unsigned _sp = 0; while (cond) { \
    if ((++_sp & 255u) == 0u) { if (xb_ld(&(bar)[XB_TMO])) break; if (_sp > XB_SPIN_CAP) { atomicAdd(&(bar)[XB_TMO], 1u); break; } } } } while (0)

struct XcdBarrier {
    unsigned* bar; unsigned x;
    volatile LAS unsigned* st;
};

__device__ __forceinline__ XcdBarrier xcd_barrier_post(unsigned* bar, volatile LAS unsigned* st) {
    XcdBarrier b; b.bar = bar; b.x = xb_xcc_id(); b.st = st;
    if (threadIdx.x == 0) (void)xb_add(&bar[XB_XCNT(b.x)], 1u);
    return b;
}
__device__ __forceinline__ void xcd_barrier_complete(unsigned* bar, unsigned x, unsigned& nloc, unsigned& nx) {
    const unsigned G = gridDim.x * gridDim.y * gridDim.z;
    unsigned sum, cnt, mine, sp = 0u;
    for (;;) {
        sum = 0u; cnt = 0u; mine = 0u;
#pragma unroll
        for (unsigned j = 0; j < 16; ++j) { const unsigned c = xb_ld(&bar[XB_XCNT(j)]); sum += c; cnt += (c > 0u) ? 1u : 0u; mine = (j == x) ? c : mine; }
        if (sum == G) break;
        __builtin_amdgcn_s_sleep(1);
        if ((++sp & 255u) == 0u) { if (xb_ld(&bar[XB_TMO])) break; if (sp > XB_SPIN_CAP) { atomicAdd(&bar[XB_TMO], 1u); break; } }
    }
    nloc = mine > 0u ? mine : 1u; nx = cnt > 0u ? cnt : 1u;
}

__device__ __forceinline__ void xcd_barrier(const XcdBarrier& b) {
    asm volatile("s_waitcnt vmcnt(0)" ::: "memory");
    __syncthreads();
    if (threadIdx.x == 0) {
        unsigned* bar = b.bar;
        __builtin_amdgcn_s_waitcnt(0);
        unsigned nloc = b.st[0], nx = b.st[1];
        if (nloc == 0u) { xcd_barrier_complete(bar, b.x, nloc, nx); b.st[0] = nloc; b.st[1] = nx; }
        const unsigned old = xb_add(&bar[XB_XSUB(b.x)], 1u);
        const unsigned gen = old / nloc;
        if (old + 1u == (gen + 1u) * nloc) {
            __builtin_amdgcn_fence(__ATOMIC_RELEASE, "agent");
            asm volatile("s_waitcnt vmcnt(0)" ::: "memory");
            const unsigned og = xb_add(&bar[XB_TOP], 1u);
            const unsigned tg = og / nx;
            if (og + 1u == (tg + 1u) * nx) { for (int j = 0; j < 16; ++j) __hip_atomic_store(&bar[XB_XGEN(j)], gen + 1u, __ATOMIC_RELAXED, __HIP_MEMORY_SCOPE_AGENT);     xb_add(&bar[XB_TOPGEN], 1u); }
            else XB_SPIN(xb_ld(&bar[XB_TOPGEN]) == tg, bar);
            __builtin_amdgcn_fence(__ATOMIC_ACQUIRE, "agent");
            __hip_atomic_store(&bar[XB_XGEN(b.x)], gen + 1u, __ATOMIC_RELAXED, __HIP_MEMORY_SCOPE_AGENT);
            asm volatile("s_waitcnt vmcnt(0)" ::: "memory");
        } else {
            XB_SPIN(xb_ld(&bar[XB_XGEN(b.x)]) == gen, bar);
            __builtin_amdgcn_fence(__ATOMIC_ACQUIRE, "agent");
            asm volatile("s_waitcnt vmcnt(0)" ::: "memory");
        }
    }
    __syncthreads();
}

constexpr int CW_BAR = 4096;
constexpr int CW_KMAX = 7680;
constexpr int MISC_OFF = 131072 + 320;
struct Args { const float* in[20]; float* out; unsigned char* ws; int ph_lo, ph_hi; };

__device__ __forceinline__ void transpose_item(const float* __restrict__ W, int K, int N, bf16* __restrict__ WT, int mode, const float* __restrict__ gk, LAS float* scr, int item, int lane) {
    const int nblk = N / 32, kb = item / nblk, nb = item % nblk, k0 = 64 * kb, n0 = 32 * nb;
#pragma unroll
    for (int i = 0; i < 8; ++i) { const int kk = 8 * i + (lane >> 3), c4 = (lane & 7) * 4;
        f32x4 v = *(const f32x4*)(W + (size_t)(k0 + kk) * N + n0 + c4); if (gk) v = v * gk[k0 + kk];
        scr[kk * 33 + c4 + 0] = v[0]; scr[kk * 33 + c4 + 1] = v[1]; scr[kk * 33 + c4 + 2] = v[2]; scr[kk * 33 + c4 + 3] = v[3]; }
    asm volatile("s_waitcnt lgkmcnt(0)" ::: "memory");
    int r0 = n0; if (mode == 1) { const int half = n0 >> 10, ch = n0 & 1023; r0 = 256 * (ch >> 7) + 128 * half + (ch & 127); }
    const int c = lane & 7;
#pragma unroll
    for (int j = 0; j < 4; ++j) { const int n = (lane >> 3) + 8 * j; const LAS float* s = scr + (8 * c) * 33 + n;
        v4u o; o.x = pk2(s[0 * 33], s[1 * 33]); o.y = pk2(s[2 * 33], s[3 * 33]); o.z = pk2(s[4 * 33], s[5 * 33]); o.w = pk2(s[6 * 33], s[7 * 33]);
        *(v4u*)(WT + (size_t)(r0 + n) * K + k0 + 8 * c) = o; }
    asm volatile("s_waitcnt lgkmcnt(0)" ::: "memory");
}

template <bool XIN_F32, bool HAS_MO, bool OUT_F32>
__device__ __forceinline__ void norm_phase(int gw, int NGW, int lane, const float* __restrict__ xf, const bf16* xb_in, const bf16* __restrict__ mo, const float* __restrict__ gpost,
                                           float* __restrict__ outf, bf16* xb_out, float* __restrict__ rs) {
    f32x4 gp[4];
#pragma unroll
    for (int j = 0; j < 4; ++j) gp[j] = HAS_MO ? *((const f32x4*)gpost + lane + 64 * j) : (f32x4){0.f, 0.f, 0.f, 0.f};
    for (int m = gw; m < M; m += NGW) {
        f32x4 v[4];
        if (XIN_F32) { const f32x4* xr = (const f32x4*)(xf + (size_t)m * D) + lane;
#pragma unroll
            for (int j = 0; j < 4; ++j) v[j] = xr[64 * j]; }
        else { const v2u* xr = (const v2u*)(xb_in + (size_t)m * D) + lane;
#pragma unroll
            for (int j = 0; j < 4; ++j) { const v2u w = xr[64 * j]; v[j] = (f32x4){bflo(w.x), bfhi(w.x), bflo(w.y), bfhi(w.y)}; } }
        if (HAS_MO) {
            const v2u* mr = (const v2u*)(mo + (size_t)m * D) + lane; f32x4 mv[4]; float ss = 0.f;
#pragma unroll
            for (int j = 0; j < 4; ++j) { const v2u w = mr[64 * j]; mv[j] = (f32x4){bflo(w.x), bfhi(w.x), bflo(w.y), bfhi(w.y)};
                ss += (mv[j][0] * mv[j][0] + mv[j][1] * mv[j][1]) + (mv[j][2] * mv[j][2] + mv[j][3] * mv[j][3]); }
            const float r = rsqrtf(wave_sum_dpp(ss) * (1.f / D) + EPS);
#pragma unroll
            for (int j = 0; j < 4; ++j) v[j] = v[j] + mv[j] * r * gp[j];
        }
        if (OUT_F32) { f32x4* xo = (f32x4*)(outf + (size_t)m * D) + lane;
#pragma unroll
            for (int j = 0; j < 4; ++j) xo[64 * j] = v[j]; }
        else { float s2 = 0.f;
#pragma unroll
            for (int j = 0; j < 4; ++j) s2 += (v[j][0] * v[j][0] + v[j][1] * v[j][1]) + (v[j][2] * v[j][2] + v[j][3] * v[j][3]);
            const float r2 = rsqrtf(wave_sum_dpp(s2) * (1.f / D) + EPS);
            if (lane == 0) rs[m] = r2;
            v2u* o8 = (v2u*)(xb_out + (size_t)m * D) + lane;
#pragma unroll
            for (int j = 0; j < 4; ++j) { v2u w; w.x = pk2(v[j][0], v[j][1]); w.y = pk2(v[j][2], v[j][3]); o8[64 * j] = w; } }
    }
}

__device__ __forceinline__ void conv_phase(int G, LAS float* red, const bf16* __restrict__ Gin, const float* __restrict__ wdw, const float* __restrict__ bdw,
                                           const float* __restrict__ lng, const float* __restrict__ lnb, bf16* __restrict__ Cout) {
    constexpr int GT = 16, WN = GT + 30, NG = 128 / GT, NS = 2 * GT;
    const int tid = threadIdx.x, lane = tid & 63, wave = tid >> 6, ch = 2 * tid;
    LAS f32x2* wl = (LAS f32x2*)(red + 2 * 8 * NS);
#pragma unroll
    for (int k = 0; k < 31; ++k) wl[k * NTHR + tid] = *(const f32x2*)(wdw + k * 1024 + ch);
    const f32x2 bb = *(const f32x2*)(bdw + ch), gg = *(const f32x2*)(lng + ch), lb = *(const f32x2*)(lnb + ch);
    const char* gbase = (const char*)Gin; const unsigned voff = (unsigned)tid * 4u;
    for (int strip = blockIdx.x; strip < M / 128; strip += G) {
        const int tb = strip * 128, sb = tb & (SEQ - 1);
        unsigned wnd[WN], nxt[GT];
#pragma unroll
        for (int i = 0; i < WN; ++i) { const int sl = sb - 15 + i; const bool ok = (sl >= 0 && sl < SEQ);
            const int row = __builtin_amdgcn_readfirstlane(ok ? tb - 15 + i : tb);
            const unsigned v = *(const unsigned*)(gbase + (size_t)row * (D * 2) + voff); wnd[i] = ok ? v : 0u; }
#pragma unroll 1
        for (int g = 0; g < NG; ++g) {
            const int t0 = tb + GT * g;
#pragma unroll
            for (int i = 0; i < GT; ++i) { const int sl = sb + GT * g + GT + 15 + i; const bool ok = (sl < SEQ) && (g < NG - 1);
                const int row = __builtin_amdgcn_readfirstlane(ok ? t0 + GT + 15 + i : tb);
                const unsigned v = *(const unsigned*)(gbase + (size_t)row * (D * 2) + voff); nxt[i] = ok ? v : 0u; }
            f32x2 acc[GT];
#pragma unroll
            for (int j = 0; j < GT; ++j) acc[j] = bb;
#pragma unroll
            for (int k = 0; k < 31; ++k) { const f32x2 w = wl[k * NTHR + tid];
#pragma unroll
                for (int j = 0; j < GT; ++j) { const f32x2 xx = {bflo(wnd[j + k]), bfhi(wnd[j + k])}; acc[j] = w * xx + acc[j]; } }
            LAS float* rb = red + (g & 1) * (8 * NS);
#pragma unroll
            for (int j = 0; j < GT; ++j) { const float s = wave_sum_dpp(acc[j].x + acc[j].y), q = wave_sum_dpp(acc[j].x * acc[j].x + acc[j].y * acc[j].y);
                if (lane == 0) { rb[j * 8 + wave] = s; rb[(GT + j) * 8 + wave] = q; } }
            __syncthreads();
#pragma unroll
            for (int j = 0; j < GT; ++j) { const f32x4 s0 = *(const LAS f32x4*)(rb + j * 8), s1 = *(const LAS f32x4*)(rb + j * 8 + 4), q0 = *(const LAS f32x4*)(rb + (GT + j) * 8), q1 = *(const LAS f32x4*)(rb + (GT + j) * 8 + 4);
                const float ts = ((s0[0] + s0[1]) + (s0[2] + s0[3])) + ((s1[0] + s1[1]) + (s1[2] + s1[3])), tq = ((q0[0] + q0[1]) + (q0[2] + q0[3])) + ((q1[0] + q1[1]) + (q1[2] + q1[3]));
                const float mu = ts * (1.f / D), var = fmaxf(tq * (1.f / D) - mu * mu, 0.f), rstd = rsqrtf(var + EPS);
                float y0 = (acc[j].x - mu) * rstd * gg.x + lb.x, y1 = (acc[j].y - mu) * rstd * gg.y + lb.y;
                y0 = y0 * __builtin_amdgcn_rcpf(1.f + __builtin_amdgcn_exp2f(-1.4426950408889634f * y0)); y1 = y1 * __builtin_amdgcn_rcpf(1.f + __builtin_amdgcn_exp2f(-1.4426950408889634f * y1));
                *(unsigned*)(Cout + (size_t)(t0 + j) * D + ch) = pk2(y0, y1); }
#pragma unroll
            for (int i = 0; i < 30; ++i) wnd[i] = wnd[i + GT];
#pragma unroll
            for (int i = 0; i < GT; ++i) wnd[30 + i] = nxt[i];
        }
    }
}

__global__ void __launch_bounds__(NTHR, 2) fwd_megakernel(Args args) {
    extern __shared__ __attribute__((aligned(16))) unsigned char lds[];
    cg::grid_group grid = cg::this_grid();
    LAS unsigned char* ldsl = (LAS unsigned char*)lds;
    const int tid = threadIdx.x, lane = tid & 63, wave = __builtin_amdgcn_readfirstlane(tid >> 6);
    const int G = gridDim.x, bx = blockIdx.x, vcu = (G % 8 == 0) ? (bx % 8) * (G / 8) + bx / 8 : bx;
    const int gw = vcu * NWAVES + wave, NGW = G * NWAVES;
    const int gt = bx * NTHR + tid, NGT = G * NTHR;
    unsigned char* ws = args.ws;
    const float* x = args.in[0]; const int* positions = (const int*)args.in[1]; const float* gains = args.in[2];
    float* out = args.out;
    bf16 *Win_t = (bf16*)(ws + WS_WIN), *Wuq_t = (bf16*)(ws + WS_WUQ), *Wukv_t = (bf16*)(ws + WS_WUKV), *Wout_t = (bf16*)(ws + WS_WOUT), *Wpw1_t = (bf16*)(ws + WS_WPW1),
         *Wpw2_t = (bf16*)(ws + WS_WPW2), *W1_t = (bf16*)(ws + WS_W1), *W2_t = (bf16*)(ws + WS_W2);
    float* CS = (float*)(ws + WS_CS); bf16* KPE = (bf16*)(ws + WS_KPE); float* SS = (float*)(ws + WS_SS); float* RS = (float*)(ws + WS_RS);
    bf16 *XN = (bf16*)(ws + WS_XN), *MO = (bf16*)(ws + WS_MO), *U = (bf16*)(ws + WS_U), *PROJ = (bf16*)(ws + WS_PROJ), *Q = (bf16*)(ws + WS_Q), *KV = (bf16*)(ws + WS_KV),
         *GB = (bf16*)(ws + WS_G), *CB = (bf16*)(ws + WS_C), *MIX = (bf16*)(ws + WS_MIX);
    const int lo = args.ph_lo, hi = args.ph_hi;
    volatile LAS unsigned* MISC = (volatile LAS unsigned*)(ldsl + MISC_OFF);
    if (tid < 32) MISC[tid] = 0u;
    __syncthreads();
    if (lo > hi) grid.sync();
    XcdBarrier bar; bar.bar = (unsigned*)ws + CW_BAR; bar.x = 0; bar.st = nullptr;
    if (hi - lo > 1) bar = xcd_barrier_post((unsigned*)ws + CW_BAR, MISC + 8);
#ifdef ONLY_PHASE
#define IN(k) ((k) == ONLY_PHASE)
#else
#define IN(k) (lo <= (k) && (k) < hi)
#endif
#define REPS(k) _Pragma("unroll") for (int rep_ = 0; rep_ < ((k) == PROBE_PHASE ? 2 : 1); ++rep_)
#define SEAM(k) do { if (IN(k) && IN((k) + 1)) xcd_barrier(bar); } while (0)

    if (IN(0)) REPS(0) {
        LAS float* scr = (LAS float*)(ldsl + wave * 16384);
        constexpr int I_IN = (D / 64) * (INC / 32), I_UQ = (QR / 64) * (NQ / 32), I_UKV = (KVR / 64) * (NKV / 32), I_OUT = (D / 64) * (D / 32), I_PW1 = (D / 64) * (2048 / 32), I_PW2 = I_OUT,
                      I_1 = (D / 64) * (FF / 32), I_2 = (FF / 64) * (D / 32);
        constexpr int NITEMS = I_IN + I_UQ + I_UKV + I_OUT + I_PW1 + I_PW2 + 2 * I_1 + 2 * I_2;
        for (int it = gw; it < NITEMS; it += NGW) {
            int r = it;
            if (r < I_IN) { transpose_item(args.in[3], D, INC, Win_t, 0, gains + 0 * D, scr, r, lane); continue; } r -= I_IN;
            if (r < I_UQ) { transpose_item(args.in[6], QR, NQ, Wuq_t, 0, args.in[5], scr, r, lane); continue; } r -= I_UQ;
            if (r < I_UKV) { transpose_item(args.in[8], KVR, NKV, Wukv_t, 0, args.in[7], scr, r, lane); continue; } r -= I_UKV;
            if (r < I_OUT) { transpose_item(args.in[9], D, D, Wout_t, 0, nullptr, scr, r, lane); continue; } r -= I_OUT;
            if (r < I_PW1) { transpose_item(args.in[10], D, 2048, Wpw1_t, 1, gains + 4 * D, scr, r, lane); continue; } r -= I_PW1;
            if (r < I_PW2) { transpose_item(args.in[16], D, D, Wpw2_t, 0, nullptr, scr, r, lane); continue; } r -= I_PW2;
            if (r < 2 * I_1) { const int l = r / I_1; transpose_item(args.in[18] + (size_t)l * D * FF, D, FF, W1_t + (size_t)l * D * FF, 0, gains + (4 * l + 2) * D, scr, r - l * I_1, lane); continue; } r -= 2 * I_1;
            { const int l = r / I_2; transpose_item(args.in[19] + (size_t)l * D * FF, FF, D, W2_t + (size_t)l * D * FF, 0, nullptr, scr, r - l * I_2, lane); }
        }
        for (int i = gt; i < (INP - INC) * D / 8; i += NGT) *((v4u*)(Win_t + (size_t)INC * D) + i) = (v4u){0u, 0u, 0u, 0u};
        for (int i = gt; i < M * 16; i += NGT) { const int tok = i >> 4, f = i & 15;
            const float inv = 1.0f / powf(10000.0f, (float)f * (1.0f / 16.0f)); const float ang = (float)positions[tok] * inv;
            CS[(size_t)tok * 32 + f] = cosf(ang); CS[(size_t)tok * 32 + 16 + f] = sinf(ang); }
        norm_phase<true, false, false>(gw, NGW, lane, x, nullptr, nullptr, nullptr, nullptr, XN, RS);
    }
    SEAM(0);
    if (IN(1)) REPS(1) {
        pg8::Gemm g{XN, Win_t, M, INP, D, D}; pg8::StaticOrder S; S.init(M, INP, G, bx);
        pg8::EpiInProj E{PROJ, INP, SS, RS};
        pg8::gemm_phase<pg8::EpiInProj, pg8::StaticOrder, true, true>(ldsl, g, S, E);
    }
    SEAM(1);
    if (IN(2)) REPS(2) {
        { pg8::Gemm g{PROJ + 1536, Wuq_t, M, NQ, QR, INP}; pg8::StaticOrder S; S.init(M, NQ, G, bx);
          pg8::EpiRowScale E{Q, NQ, SS, 0, 3, 1.f / QR, EPS, nullptr};
          pg8::gemm_phase<pg8::EpiRowScale, pg8::StaticOrder, true, true>(ldsl, g, S, E); }
        { pg8::Gemm g{PROJ + 1920, Wukv_t, M, NKV, KVR, INP}; pg8::StaticOrder S; S.init(M, NKV, G, bx);
          pg8::EpiRowScale E{KV, NKV, SS, 3, 2, 1.f / KVR, EPS, (unsigned*)ws + CW_KMAX};
          pg8::gemm_phase<pg8::EpiRowScale, pg8::StaticOrder, true, true>(ldsl, g, S, E); }
        const float* sck = args.in[4];
        const int nslot = (G == 256) ? 384 : G, slot0 = (G == 256 && bx >= 128) ? 128 + 2 * (bx - 128) : bx, myslots = (G == 256 && bx >= 128) ? 2 : 1;
        { const int c = (tid & 63) * 8;
          float wk[3][8];
#pragma unroll
          for (int k = 0; k < 3; ++k)
#pragma unroll
            for (int j = 0; j < 8; ++j) wk[k][j] = sck[k * 512 + c + j];
          const int mstep = nslot * (NTHR / 64);
          for (int sl = 0; sl < myslots; ++sl)
          for (int m0 = (slot0 + sl) * (NTHR / 64) + (tid >> 6); m0 < M; m0 += 2 * mstep) {
            bf16x8 gb[2], c0[2], c1[2], c2[2], x0[2], x1[2], x2[2]; int mm[2];
#pragma unroll
            for (int q = 0; q < 2; ++q) { const int m = (m0 + q * mstep < M) ? m0 + q * mstep : m0, s = m & (SEQ - 1); mm[q] = m;
                const bf16* p = PROJ + (size_t)m * INP; const bool okl = s > 0, okr = s < SEQ - 1;
                const bf16* pl = okl ? p - INP : p; const bf16* pr = okr ? p + INP : p;
                gb[q] = *(const bf16x8*)(p + c); c1[q] = *(const bf16x8*)(p + 512 + c); x1[q] = *(const bf16x8*)(p + 1024 + c);
                c0[q] = *(const bf16x8*)(pl + 512 + c); x0[q] = *(const bf16x8*)(pl + 1024 + c); c2[q] = *(const bf16x8*)(pr + 512 + c); x2[q] = *(const bf16x8*)(pr + 1024 + c);
                const bf16x8 zz = {0, 0, 0, 0, 0, 0, 0, 0}; if (!okl) c0[q] = zz; if (!okr) c2[q] = zz; }
#pragma unroll
            for (int q = 0; q < 2; ++q) if (q == 0 || m0 + mstep < M) { float y[8];
#pragma unroll
                for (int j = 0; j < 8; ++j) { const float u0 = att::bf2f(c0[q][j]) * att::bf2f(x0[q][j]), u1 = att::bf2f(c1[q][j]) * att::bf2f(x1[q][j]), u2 = att::bf2f(c2[q][j]) * att::bf2f(x2[q][j]);
                    y[j] = att::bf2f(gb[q][j]) * (wk[0][j] * u0 + wk[1][j] * u1 + wk[2][j] * u2); }
                v4u o; o.x = pk2(y[0], y[1]); o.y = pk2(y[2], y[3]); o.z = pk2(y[4], y[5]); o.w = pk2(y[6], y[7]);
                *(v4u*)(MIX + (size_t)mm[q] * D + c) = o; } } }
        float wq0 = 0.f, wq1 = 0.f, wq2 = 0.f, wq3 = 0.f;
        for (int it = gt; it < M * 16; it += NGT) { const int m = it >> 4, f = it & 15;
            const float x1 = bflo((unsigned)PROJ[(size_t)m * INP + 2176 + f]), x2 = bflo((unsigned)PROJ[(size_t)m * INP + 2192 + f]);
            const float c = CS[(size_t)m * 32 + f], sn = CS[(size_t)m * 32 + 16 + f];
            KPE[(size_t)m * 32 + f] = (bf16)(pk2(x1 * c - x2 * sn, 0.f) & 0xffffu); KPE[(size_t)m * 32 + 16 + f] = (bf16)(pk2(x2 * c + x1 * sn, 0.f) & 0xffffu);
            float q = x1 * x1 + x2 * x2;
            q += dpp_get<0xB1>(q); q += dpp_get<0x4E>(q); q += dpp_get<0x141>(q); q += dpp_get<0x140>(q);
            { auto rr = __builtin_amdgcn_permlane16_swap(__float_as_uint(q), __float_as_uint(q), false, false); q = fmaxf(__uint_as_float(rr[0]), __uint_as_float(rr[1])); }
            { auto rr = __builtin_amdgcn_permlane32_swap(__float_as_uint(q), __float_as_uint(q), false, false); q = fmaxf(__uint_as_float(rr[0]), __uint_as_float(rr[1])); }
            const int b = m >> 13;
            wq0 = (b == 0) ? fmaxf(wq0, q) : wq0; wq1 = (b == 1) ? fmaxf(wq1, q) : wq1; wq2 = (b == 2) ? fmaxf(wq2, q) : wq2; wq3 = (b == 3) ? fmaxf(wq3, q) : wq3; }
        {
            LAS float* wm = (LAS float*)ldsl;
            if (lane == 0) *(LAS f32x4*)(wm + wave * 4) = (f32x4){wq0, wq1, wq2, wq3};
            __syncthreads();
            if (tid < 4) { float v = wm[tid];
#pragma unroll
                for (int w = 1; w < 8; ++w) v = fmaxf(v, wm[w * 4 + tid]);
                __hip_atomic_fetch_max((unsigned*)ws + CW_KMAX + (tid * 8) * 4 + 3, __float_as_uint(v), __ATOMIC_RELAXED, __HIP_MEMORY_SCOPE_AGENT); }
            __syncthreads(); }
    }
    SEAM(2);
    if (IN(3)) REPS(3) {
        constexpr int NU = BATCH * 8 * (SEQ / 256);
        for (int u = vcu; u < NU; u += G) {
            const int unit = u;
            const int bh = unit >> 5, qb = unit & 31, b = bh >> 3, h = bh & 7; const size_t rowbase = (size_t)b * SEQ, q0 = (size_t)qb * 256;
            const unsigned* kmw = (const unsigned*)ws + CW_KMAX;
            const float kmax = sqrtf(__uint_as_float(kmw[bh * 4 + 0]) + __uint_as_float(kmw[bh * 4 + 1]) + __uint_as_float(kmw[(b * 8) * 4 + 3])) * 1.01f;
            att::attn_unit(Q + (rowbase + q0) * NQ + h * 96, KV + rowbase * NKV + h * 128, KPE + rowbase * 32, CS + (rowbase + q0) * 32,
                           MIX + (rowbase + q0) * D + 512 + h * 64, (char*)lds, kmax);
        }
    }
    SEAM(3);
    if (IN(4)) REPS(4) {
        pg8::Gemm g{MIX, Wout_t, M, D, D, D}; pg8::StaticOrder S; S.init(M, D, G, bx);
        pg8::EpiPlain<0> E{MO, D, nullptr, nullptr};
        pg8::gemm_phase<pg8::EpiPlain<0>, pg8::StaticOrder, true, true>(ldsl, g, S, E);
    }
    SEAM(4);
    if (IN(5)) REPS(5) norm_phase<false, true, false>(gw, NGW, lane, nullptr, XN, MO, gains + 1 * D, nullptr, XN, RS);
    SEAM(5);
    if (IN(6)) REPS(6) {
        pg8::Gemm g{XN, W1_t, M, FF, D, D}; pg8::StaticOrder S; S.init(M, FF, G, bx);
        pg8::EpiPlain<1> E{U, FF, nullptr, RS};
        pg8::gemm_phase<pg8::EpiPlain<1>, pg8::StaticOrder, true, true>(ldsl, g, S, E);
    }
    SEAM(6);
    if (IN(7)) REPS(7) {
        pg8::Gemm g{U, W2_t, M, D, FF, FF}; pg8::StaticOrder S; S.init(M, D, G, bx, 1);
        pg8::EpiPlain<0> E{MO, D, nullptr, nullptr};
        pg8::gemm_phase<pg8::EpiPlain<0>, pg8::StaticOrder, true, true>(ldsl, g, S, E);
    }
    SEAM(7);
    if (IN(8)) REPS(8) norm_phase<false, true, false>(gw, NGW, lane, nullptr, XN, MO, gains + 3 * D, nullptr, XN, RS);
    SEAM(8);
    if (IN(9)) REPS(9) {
        pg8::Gemm g{XN, Wpw1_t, M, 2048, D, D}; pg8::StaticOrder S; S.init(M, 2048, G, bx);
        pg8::EpiGLU E{GB, D, args.in[11], RS};
        pg8::gemm_phase<pg8::EpiGLU, pg8::StaticOrder, true, true>(ldsl, g, S, E);
    }
    SEAM(9);
    if (IN(10)) REPS(10) conv_phase(G, (LAS float*)ldsl, GB, args.in[12], args.in[13], args.in[14], args.in[15], CB);
    SEAM(10);
    if (IN(11)) REPS(11) {
        pg8::Gemm g{CB, Wpw2_t, M, D, D, D}; pg8::StaticOrder S; S.init(M, D, G, bx);
        pg8::EpiPlain<0> E{MO, D, args.in[17], nullptr};
        pg8::gemm_phase<pg8::EpiPlain<0>, pg8::StaticOrder, true, true>(ldsl, g, S, E);
    }
    SEAM(11);
    if (IN(12)) REPS(12) norm_phase<false, true, false>(gw, NGW, lane, nullptr, XN, MO, gains + 5 * D, nullptr, XN, RS);
    SEAM(12);
    if (IN(13)) REPS(13) {
        pg8::Gemm g{XN, W1_t + (size_t)D * FF, M, FF, D, D}; pg8::StaticOrder S; S.init(M, FF, G, bx);
        pg8::EpiPlain<1> E{U, FF, nullptr, RS};
        pg8::gemm_phase<pg8::EpiPlain<1>, pg8::StaticOrder, true, true>(ldsl, g, S, E);
    }
    SEAM(13);
    if (IN(14)) REPS(14) {
        pg8::Gemm g{U, W2_t + (size_t)D * FF, M, D, FF, FF}; pg8::StaticOrder S; S.init(M, D, G, bx, 1);
        pg8::EpiPlain<0> E{MO, D, nullptr, nullptr};
        pg8::gemm_phase<pg8::EpiPlain<0>, pg8::StaticOrder, true, true>(ldsl, g, S, E);
    }
    SEAM(14);
    if (IN(15)) REPS(15) norm_phase<false, true, true>(gw, NGW, lane, nullptr, XN, MO, gains + 7 * D, out, nullptr, nullptr);
#undef IN
#undef SEAM
}

extern "C" void kernel_launch(void* const* d_in, const int* in_sizes, int n_in, void* d_out, int out_size, void* d_ws, size_t ws_size, hipStream_t stream) {
    static int grid = 0;
    if (grid == 0) {
        if (n_in != 20 || in_sizes[0] != M * D || out_size != M * D || ws_size < WS_END) {
            fprintf(stderr, "kernel_launch: shape mismatch: n_in %d in0 %d out %d ws %zu (need %zu)\n", n_in, n_in > 0 ? in_sizes[0] : -1, out_size, ws_size, (size_t)WS_END); grid = -1; return; }
        int dev = 0, cus = 0, per_cu = 0;
        if (hipGetDevice(&dev) != hipSuccess || hipDeviceGetAttribute(&cus, hipDeviceAttributeMultiprocessorCount, dev) != hipSuccess) { grid = -1; return; }
        if (hipFuncSetAttribute((const void*)fwd_megakernel, hipFuncAttributeMaxDynamicSharedMemorySize, LDS_BYTES) != hipSuccess) { fprintf(stderr, "kernel_launch: hipFuncSetAttribute failed\n"); grid = -1; return; }
        if (hipOccupancyMaxActiveBlocksPerMultiprocessor(&per_cu, (const void*)fwd_megakernel, NTHR, LDS_BYTES) != hipSuccess || per_cu < 1) { fprintf(stderr, "kernel_launch: occupancy query says %d\n", per_cu); per_cu = 1; }
        (void)hipGetLastError();
        grid = cus;
    }
    if (grid < 0) return;
    if (hipMemsetAsync(d_ws, 0, 32768, stream) != hipSuccess) { fprintf(stderr, "kernel_launch: memset failed\n"); return; }
    Args a{};
    for (int i = 0; i < 20; ++i) a.in[i] = (const float*)d_in[i];
    a.out = (float*)d_out; a.ws = (unsigned char*)d_ws;
#if MK_PER_PHASE
    for (int p = 0; p < N_PHASES; ++p) { a.ph_lo = p; a.ph_hi = p + 1; hipLaunchKernelGGL(fwd_megakernel, dim3(grid), dim3(NTHR), LDS_BYTES, stream, a); }
#else
    a.ph_lo = 0; a.ph_hi = N_PHASES;
    void* kargs[] = {&a};
    hipError_t e = hipLaunchCooperativeKernel((const void*)fwd_megakernel, dim3(grid), dim3(NTHR), kargs, LDS_BYTES, stream);
    if (e != hipSuccess) fprintf(stderr, "kernel_launch: cooperative launch failed: %s (grid %d)\n", hipGetErrorString(e), grid);
#endif
}
```
